# Optimizing an MI355X kernel written in HIP

```python
import jax, jax.numpy as jnp
from jax import lax
import numpy as np

D_MODEL = 2048
BATCH = 4
SEQ = 2048
DEPTH = 1
DEC_BATCH = 128
DEC_SEQ = 4
PAST_LEN = 16384
PAGE_SIZE = 128

CHUNK = 128
W_A = D_MODEL
N_GROUPS_A = 16
GROUP_A = W_A // N_GROUPS_A
W_B = D_MODEL
CONV_K = 3
D_FF = (11 * D_MODEL) // 4
IN_WIDTH = 2 * W_A + 3 * W_B + 2 * D_MODEL
N_MOD = 6
EPS = 1e-6

kernel_name = "hybrid_gmlp_shortconv_convffn_decoder_step"


def rmsnorm(x, g):
    xf = x.astype(jnp.float32)
    y = xf * lax.rsqrt(jnp.mean(xf * xf, axis=-1, keepdims=True) + EPS)
    return (y * g.astype(jnp.float32)).astype(x.dtype)


def causal_dwconv(x, buf, w):
    T = x.shape[1]
    xp = jnp.concatenate([buf.astype(x.dtype), x], axis=1)
    y = w[0] * xp[:, 0:T]
    for k in range(1, CONV_K):
        y = y + w[k] * xp[:, k:k + T]
    return y, xp[:, -(CONV_K - 1):]


def spatial_gate(v, w_s, b_s):
    Bn, T, _ = v.shape
    L = min(T, CHUNK)
    n = T // L
    mask = jnp.tril(jnp.ones((L, L), dtype=bool))
    w = jnp.where(mask, w_s[:, :L, :L], 0).astype(v.dtype)
    vc = v.reshape(Bn, n, L, N_GROUPS_A, GROUP_A)
    s = jnp.einsum('gts,bnsgd->bntgd', w, vc)
    s = s + jnp.transpose(b_s[:, :L])[None, None, :, :, None].astype(v.dtype)
    return s.reshape(Bn, T, W_A)


def decoder_layer(x, c, conv_b_buf, conv_f_buf, w_ada, b_ada, g_pre_mix, g_post_mix, w_in, g_v,
                  w_s, b_s, conv_b_w, w_out_a, w_out_b, w_o, g_pre_ffn, g_post_ffn, w_up,
                  conv_f_w, w_down):
    mod = jax.nn.silu(c) @ w_ada + b_ada
    sh1, sc1, gt1, sh2, sc2, gt2 = jnp.split(mod[:, None, :], N_MOD, axis=-1)

    h = rmsnorm(x, g_pre_mix) * (1 + sc1) + sh1
    z = h @ w_in
    cuts = [W_A, 2 * W_A, 2 * W_A + W_B, 2 * W_A + 2 * W_B, 2 * W_A + 3 * W_B,
            2 * W_A + 3 * W_B + D_MODEL]
    u, v, bg, cg, xb, ga, gb = jnp.split(z, cuts, axis=-1)
    v = rmsnorm(v, g_v)
    ya = u * spatial_gate(v, w_s, b_s)
    cb, new_b_buf = causal_dwconv(cg * xb, conv_b_buf, conv_b_w)
    yb = bg * cb
    merged = jax.nn.sigmoid(ga) * (ya @ w_out_a) + jax.nn.sigmoid(gb) * (yb @ w_out_b)
    x = x + gt1 * rmsnorm(merged @ w_o, g_post_mix)

    h = rmsnorm(x, g_pre_ffn) * (1 + sc2) + sh2
    a, b = jnp.split(h @ w_up, 2, axis=-1)
    a, new_f_buf = causal_dwconv(a, conv_f_buf, conv_f_w)
    f = (jax.nn.gelu(a) * b) @ w_down
    x = x + gt2 * rmsnorm(f, g_post_ffn)
    return x, new_b_buf, new_f_buf, v


def setup_inputs(seed: int = 0) -> dict:
    key = jax.random.key(seed)
    ks = jax.random.split(key, 24)
    nrm = lambda k, shape, s: jax.random.normal(k, shape, jnp.float32) * s
    gain = lambda k, n: 1.0 + 0.01 * jax.random.normal(k, (DEPTH, n), jnp.float32)
    return {
        "x_prompt": nrm(ks[0], (BATCH, SEQ, D_MODEL), 1.0),
        "x_sample": nrm(ks[1], (DEC_BATCH, DEC_SEQ, D_MODEL), 1.0),
        "c_prompt": nrm(ks[2], (BATCH, D_MODEL), 1.0),
        "c_sample": nrm(ks[3], (DEC_BATCH, D_MODEL), 1.0),
        "state_conv_b": nrm(ks[4], (DEPTH, DEC_BATCH, CONV_K - 1, W_B), 1.0),
        "state_conv_ffn": nrm(ks[5], (DEPTH, DEC_BATCH, CONV_K - 1, D_FF), 1.0),
        "w_ada": nrm(ks[6], (DEPTH, D_MODEL, N_MOD * D_MODEL), 0.5 * D_MODEL ** -0.5),
        "b_ada": nrm(ks[7], (DEPTH, N_MOD * D_MODEL), 0.01),
        "g_pre_mix": gain(ks[8], D_MODEL),
        "g_post_mix": gain(ks[9], D_MODEL),
        "w_in": nrm(ks[10], (DEPTH, D_MODEL, IN_WIDTH), D_MODEL ** -0.5),
        "g_v": gain(ks[11], W_A),
        "w_s": nrm(ks[12], (DEPTH, N_GROUPS_A, CHUNK, CHUNK), CHUNK ** -0.5),
        "b_s": 1.0 + nrm(ks[13], (DEPTH, N_GROUPS_A, CHUNK), 0.1),
        "conv_b_w": nrm(ks[14], (DEPTH, CONV_K, W_B), CONV_K ** -0.5),
        "w_out_a": nrm(ks[15], (DEPTH, W_A, D_MODEL), W_A ** -0.5),
        "w_out_b": nrm(ks[16], (DEPTH, W_B, D_MODEL), W_B ** -0.5),
        "w_o": nrm(ks[17], (DEPTH, D_MODEL, D_MODEL), D_MODEL ** -0.5),
        "g_pre_ffn": gain(ks[18], D_MODEL),
        "g_post_ffn": gain(ks[19], D_MODEL),
        "w_up": nrm(ks[20], (DEPTH, D_MODEL, 2 * D_FF), D_MODEL ** -0.5),
        "conv_f_w": nrm(ks[21], (DEPTH, CONV_K, D_FF), CONV_K ** -0.5),
        "w_down": nrm(ks[22], (DEPTH, D_FF, D_MODEL), D_FF ** -0.5),
    }


def reference(x_prompt, x_sample, c_prompt, c_sample, state_conv_b, state_conv_ffn, w_ada, b_ada,
              g_pre_mix, g_post_mix, w_in, g_v, w_s, b_s, conv_b_w, w_out_a, w_out_b, w_o,
              g_pre_ffn, g_post_ffn, w_up, conv_f_w, w_down):
    xp, xs = x_prompt, x_sample
    pb_list, sb_list, pf_list, sf_list, sv_list = [], [], [], [], []
    for l in range(DEPTH):
        params = (w_ada[l], b_ada[l], g_pre_mix[l], g_post_mix[l], w_in[l], g_v[l], w_s[l], b_s[l],
                  conv_b_w[l], w_out_a[l], w_out_b[l], w_o[l], g_pre_ffn[l], g_post_ffn[l],
                  w_up[l], conv_f_w[l], w_down[l])
        zero_b = jnp.zeros((xp.shape[0], CONV_K - 1, W_B), xp.dtype)
        zero_f = jnp.zeros((xp.shape[0], CONV_K - 1, D_FF), xp.dtype)
        xp, pb, pf, _ = decoder_layer(xp, c_prompt, zero_b, zero_f, *params)
        xs, sb, sf, sv = decoder_layer(xs, c_sample, state_conv_b[l], state_conv_ffn[l], *params)
        pb_list.append(pb)
        sb_list.append(sb)
        pf_list.append(pf)
        sf_list.append(sf)
        sv_list.append(sv)
    return (xp, xs, jnp.stack(pb_list), jnp.stack(sb_list), jnp.stack(pf_list),
            jnp.stack(sf_list), jnp.stack(sv_list))
```

```cpp
#include <hip/hip_runtime.h>
#include <cstdio>
#include <cstdint>

#define LAS __attribute__((address_space(3)))
#define GAS __attribute__((address_space(1)))
typedef unsigned short bf16_t;
typedef short bf16x8 __attribute__((ext_vector_type(8)));
typedef float f32x4 __attribute__((ext_vector_type(4)));
typedef float f32x2 __attribute__((ext_vector_type(2)));
typedef unsigned u32x4 __attribute__((ext_vector_type(4)));
typedef unsigned u32x2 __attribute__((ext_vector_type(2)));

constexpr int DM = 2048, NB = 4, SEQ = 2048, DB = 128, DS = 4, DFF = 5632, INW = 14336, NMODC = 6 * DM;
constexpr int MP = NB * SEQ, MS = DB * DS, M = MP + MS;
constexpr int NBIDX = NB + DB;
constexpr float EPS = 1e-6f;

constexpr size_t MiB = 1u << 20;
constexpr size_t WS_CTL = 0, CTL_ZERO_BYTES = 1 * MiB;
constexpr size_t WS_S = 1 * MiB;
constexpr size_t WS_MOD = 2 * MiB;
constexpr size_t WS_VSS = 14 * MiB;
constexpr size_t WS_WIN = 16 * MiB;
constexpr size_t WS_WB = 72 * MiB, WS_WA = 80 * MiB, WS_WO = 88 * MiB;
constexpr size_t WS_WUP = 96 * MiB;
constexpr size_t WS_WD = 140 * MiB;
constexpr size_t WS_R1 = 162 * MiB;
constexpr size_t SLOT = 34 * MiB;
constexpr size_t WS_H1 = WS_R1, WS_YA = WS_R1, WS_H2 = WS_R1, WS_YB = WS_R1 + SLOT, WS_WADA = WS_R1;
constexpr size_t WS_R2 = 230 * MiB;
constexpr size_t WS_U = WS_R2, WS_V = WS_R2 + SLOT, WS_BG = WS_R2 + 2 * SLOT, WS_P = WS_R2 + 3 * SLOT, WS_SGA = WS_R2 + 4 * SLOT, WS_SGB = WS_R2 + 5 * SLOT;
constexpr size_t WS_MERGED = WS_R2, WS_T = WS_R2 + SLOT, WS_F = WS_R2;
constexpr size_t WS_AUP = WS_R2, WS_BUP = WS_R2 + 94 * MiB;
constexpr size_t WS_G = 16 * MiB;
constexpr size_t WS_END = 434 * MiB;
static_assert(WS_G + (size_t)M * DFF * 2 <= WS_WD, "G overlay must stay clear of WdT");
static_assert(WS_BUP + (size_t)M * DFF * 2 <= WS_END, "ws map");
static_assert((size_t)M * DM * 2 == SLOT, "slot size");

constexpr size_t O_Y = 0, O_CBP = (size_t)M * DM, O_CBS = O_CBP + (size_t)NB * 2 * DM, O_CFP = O_CBS + (size_t)DB * 2 * DM,
                 O_CFS = O_CFP + (size_t)NB * 2 * DFF, O_CV = O_CFS + (size_t)DB * 2 * DFF, O_END = O_CV + (size_t)MS * DM;

namespace pg8 {
constexpr int BM = 256, BK = 64, HALF = 128, HTB = HALF * BK * 2, STAGE_BYTES = 8 * HTB, NXCD = 8, WGM = 8;
__host__ __device__ __forceinline__ int lds_byte(int r, int c) { const int st = (r >> 4) * 2 + (c >> 5), rr = r & 15, cc = c & 31, ob = rr * 64 + cc * 2; return st * 1024 + (ob ^ (((ob >> 9) & 1) << 5)); }
__host__ __device__ __forceinline__ void stage_rc(int b, int& R, int& C) { const int st = b / 1024, sb = b % 1024, swz = sb ^ (((sb >> 9) & 1) << 5); R = (st >> 1) * 16 + swz / 64; C = (st & 1) * 32 + (swz % 64) / 2; }
__host__ __device__ __forceinline__ int perm32(int rho) { const int n = rho >> 4, i = rho & 15; return 8 * (i >> 2) + 4 * n + (i & 3); }

struct Unit { int pm, pn, part; };

struct StaticOrder {
    int nM, nN, nwg, G, c, parts;
    __device__ void init(int nM_, int nN_, int G_, int c_, int parts_) { nM = nM_; nN = nN_; nwg = nM * nN; G = G_; c = c_; parts = parts_; }
    __device__ bool next(int i, Unit& u) const {
        const int ti = (parts == 2) ? (i >> 1) : i; u.part = (parts == 2) ? (i & 1) : 0;
        const long L = (long)ti * G + c; if (L >= nwg) return false;
        int wgid = (int)L; { const int q = nwg / NXCD, r = nwg % NXCD, xcd = wgid % NXCD, off = wgid / NXCD; wgid = (xcd < r ? xcd * (q + 1) : r * (q + 1) + (xcd - r) * q) + off; }
        const int nig = WGM * nN, gid = wgid / nig, fm = gid * WGM, gsz = (nM - fm) < WGM ? (nM - fm) : WGM;
        u.pm = fm + ((wgid % nig) % gsz); u.pn = (wgid % nig) / gsz; return true;
    }
};

struct Ptrs {
    const bf16_t* A0; const bf16_t* B0; const bf16_t* A1; const bf16_t* B1; int lda, ldb;
    __device__ __forceinline__ const char* a(const Unit& u) const { return (const char*)((u.part ? A1 : A0) + (size_t)u.pm * BM * lda); }
    __device__ __forceinline__ const char* b(const Unit& u) const { return (const char*)((u.part ? B1 : B0) + (size_t)u.pn * BM * ldb); }
};

__device__ __forceinline__ unsigned cvt_pk_bf16(float lo, float hi) { unsigned r; asm volatile("v_cvt_pk_bf16_f32 %0, %1, %2" : "=v"(r) : "v"(lo), "v"(hi)); return r; }
__device__ __forceinline__ float bf_lo(unsigned w) { return __builtin_bit_cast(float, w << 16); }
__device__ __forceinline__ float bf_hi(unsigned w) { return __builtin_bit_cast(float, w & 0xffff0000u); }
__device__ __forceinline__ float sigmoidf_(float x) { return __builtin_amdgcn_rcpf(1.0f + __builtin_amdgcn_exp2f(-1.4426950409f * x)); }

typedef f32x4 Acc[2][2][4][2];

__device__ __forceinline__ u32x4 pack8(const f32x4& v0, const f32x4& v1) { u32x4 w; w.x = cvt_pk_bf16(v0[0], v0[1]); w.y = cvt_pk_bf16(v0[2], v0[3]); w.z = cvt_pk_bf16(v1[0], v1[1]); w.w = cvt_pk_bf16(v1[2], v1[3]); return w; }

struct EpiF32 {
    static constexpr bool PERM = false;
    float* C; int ldc; const float* bias;
    __device__ __forceinline__ bool keep(const Unit&) const { return false; }
    __device__ __forceinline__ void operator()(Acc& acc, const Unit& u, int wr, int wc, int fr, int fq) const {
        const int row0 = u.pm * BM + wr * 64 + fr, col0 = u.pn * BM + wc * 32 + 4 * fq;
        f32x4 bv[2][2];
#pragma unroll
        for (int bj = 0; bj < 2; ++bj)
#pragma unroll
            for (int n = 0; n < 2; ++n) bv[bj][n] = *(const f32x4*)(bias + col0 + bj * HALF + n * 16);
#pragma unroll
        for (int ai = 0; ai < 2; ++ai)
#pragma unroll
            for (int m = 0; m < 4; ++m) { float* rowp = C + (size_t)(row0 + ai * HALF + m * 16) * ldc + col0;
#pragma unroll
                for (int bj = 0; bj < 2; ++bj)
#pragma unroll
                    for (int n = 0; n < 2; ++n) *(f32x4*)(rowp + bj * HALF + n * 16) = acc[ai][bj][m][n] + bv[bj][n]; }
    }
};

struct EpiBf16 {
    static constexpr bool PERM = true;
    bf16_t* O; int ldc;
    __device__ __forceinline__ bool keep(const Unit&) const { return false; }
    __device__ __forceinline__ void operator()(Acc& acc, const Unit& u, int wr, int wc, int fr, int fq) const {
        const int row0 = u.pm * BM + wr * 64 + fr, col0 = u.pn * BM + wc * 32 + 8 * fq;
#pragma unroll
        for (int ai = 0; ai < 2; ++ai)
#pragma unroll
            for (int m = 0; m < 4; ++m) { bf16_t* rowp = O + (size_t)(row0 + ai * HALF + m * 16) * ldc + col0;
#pragma unroll
                for (int bj = 0; bj < 2; ++bj) *(u32x4*)(rowp + bj * HALF) = pack8(acc[ai][bj][m][0], acc[ai][bj][m][1]); }
    }
};

struct EpiIn {
    static constexpr bool PERM = true;
    bf16_t *U, *V, *BG, *P, *SGA, *SGB; float* VSS;
    __device__ __forceinline__ bool keep(const Unit&) const { return false; }
    __device__ __forceinline__ void operator()(Acc& acc, const Unit& u, int wr, int wc, int fr, int fq) const {
        const int row0 = u.pm * BM + wr * 64 + fr; const int pn = u.pn;
        if (pn >= 24 && pn < 40) {
            const int col0 = (pn - 24) * HALF + wc * 32 + 8 * fq;
#pragma unroll
            for (int ai = 0; ai < 2; ++ai)
#pragma unroll
                for (int m = 0; m < 4; ++m) {
                    const f32x4 p0 = acc[ai][0][m][0] * acc[ai][1][m][0], p1 = acc[ai][0][m][1] * acc[ai][1][m][1];
                    *(u32x4*)(P + (size_t)(row0 + ai * HALF + m * 16) * DM + col0) = pack8(p0, p1); }
            return;
        }
        bf16_t* O; int ct; bool sig = false, ss = false;
        if (pn < 8) { O = U; ct = pn; } else if (pn < 16) { O = V; ct = pn - 8; ss = true; } else if (pn < 24) { O = BG; ct = pn - 16; }
        else if (pn < 48) { O = SGA; ct = pn - 40; sig = true; } else { O = SGB; ct = pn - 48; sig = true; }
        const int col0 = ct * BM + wc * 32 + 8 * fq;
#pragma unroll
        for (int ai = 0; ai < 2; ++ai)
#pragma unroll
            for (int m = 0; m < 4; ++m) {
                const int row = row0 + ai * HALF + m * 16; bf16_t* rowp = O + (size_t)row * DM + col0;
                if (ss) { float s = 0.f;
#pragma unroll
                    for (int bj = 0; bj < 2; ++bj)
#pragma unroll
                        for (int n = 0; n < 2; ++n) { const f32x4 x = acc[ai][bj][m][n]; s += (x[0] * x[0] + x[1] * x[1]) + (x[2] * x[2] + x[3] * x[3]); }
                    s += __shfl_xor(s, 16); s += __shfl_xor(s, 32);
                    if (fq == 0) VSS[(size_t)row * 32 + ct * 4 + wc] = s; }
#pragma unroll
                for (int bj = 0; bj < 2; ++bj) { f32x4 v0 = acc[ai][bj][m][0], v1 = acc[ai][bj][m][1];
                    if (sig) {
#pragma unroll
                        for (int i = 0; i < 4; ++i) { v0[i] = sigmoidf_(v0[i]); v1[i] = sigmoidf_(v1[i]); } }
                    *(u32x4*)(rowp + bj * HALF) = pack8(v0, v1); } }
    }
};

struct EpiOut {
    static constexpr bool PERM = true;
    const bf16_t *SGA, *SGB; bf16_t* O;
    __device__ __forceinline__ bool keep(const Unit& u) const { return u.part == 0; }
    __device__ __forceinline__ void operator()(Acc& acc, const Unit& u, int wr, int wc, int fr, int fq) const {
        const int row0 = u.pm * BM + wr * 64 + fr, col0 = u.pn * BM + wc * 32 + 8 * fq;
#pragma unroll
        for (int ai = 0; ai < 2; ++ai)
#pragma unroll
            for (int m = 0; m < 4; ++m) { const size_t off = (size_t)(row0 + ai * HALF + m * 16) * DM + col0;
#pragma unroll
                for (int bj = 0; bj < 2; ++bj) {
                    const u32x4 a = *(const u32x4*)(SGA + off + bj * HALF);
                    f32x4 a0 = {bf_lo(a.x), bf_hi(a.x), bf_lo(a.y), bf_hi(a.y)}, a1 = {bf_lo(a.z), bf_hi(a.z), bf_lo(a.w), bf_hi(a.w)};
                    if (u.part == 0) {
                        const u32x4 b = *(const u32x4*)(SGB + off + bj * HALF);
                        const f32x4 b0 = {bf_lo(b.x), bf_hi(b.x), bf_lo(b.y), bf_hi(b.y)}, b1 = {bf_lo(b.z), bf_hi(b.z), bf_lo(b.w), bf_hi(b.w)};
#pragma unroll
                        for (int i = 0; i < 4; ++i) { acc[ai][bj][m][0][i] *= b0[i] * __builtin_amdgcn_rcpf(a0[i]); acc[ai][bj][m][1][i] *= b1[i] * __builtin_amdgcn_rcpf(a1[i]); }
                    } else {
                        *(u32x4*)(O + off + bj * HALF) = pack8(acc[ai][bj][m][0] * a0, acc[ai][bj][m][1] * a1);
                    } }
                asm volatile("" ::: "memory"); }
    }
};

struct EpiUp {
    static constexpr bool PERM = true;
    bf16_t *A, *B;
    __device__ __forceinline__ bool keep(const Unit&) const { return false; }
    __device__ __forceinline__ void operator()(Acc& acc, const Unit& u, int wr, int wc, int fr, int fq) const {
        const int row0 = u.pm * BM + wr * 64 + fr, col0 = u.pn * HALF + wc * 32 + 8 * fq;
#pragma unroll
        for (int ai = 0; ai < 2; ++ai)
#pragma unroll
            for (int m = 0; m < 4; ++m) { const size_t off = (size_t)(row0 + ai * HALF + m * 16) * DFF + col0;
                *(u32x4*)(A + off) = pack8(acc[ai][0][m][0], acc[ai][0][m][1]);
                *(u32x4*)(B + off) = pack8(acc[ai][1][m][0], acc[ai][1][m][1]); }
    }
};

template <class Epi, class Sched, bool ALIGN_EPI, bool SP2>
__device__ __forceinline__ void gemm_phase(LAS unsigned char* lds, const Ptrs g, const int K, const Sched& S, const Epi& E) {
    const int tid = threadIdx.x, wid = __builtin_amdgcn_readfirstlane(tid >> 6), lane = tid & 63, wr = wid >> 2, wc = wid & 3, fr = lane & 15, fq = lane >> 4;
    const int nt = K / BK;
    unsigned voffA[2], voffB[2];
#pragma unroll
    for (int i = 0; i < 2; ++i) { int R, C; stage_rc(tid * 16 + i * 8192, R, C); const int Rb = Epi::PERM ? ((R & ~31) + perm32(R & 31)) : R;
        voffA[i] = (unsigned)(R * g.lda + C) * 2u; voffB[i] = (unsigned)(Rb * g.ldb + C) * 2u; }
    const size_t kstep = (size_t)(BK * 2);
    const size_t hstepA = (size_t)HALF * g.lda * 2, hstepB = (size_t)HALF * g.ldb * 2;
    const unsigned ldsw = (unsigned)wid * 1024u;
    const int aoff = lds_byte(wr * 64 + fr, fq * 8), boff = lds_byte(wc * 32 + fr, fq * 8);
#define PG8_SA(b, h) (((b) * 2 + (h)) * HTB)
#define PG8_SB(b, h) ((4 + (b) * 2 + (h)) * HTB)
#define PG8_STAGE(bufoff, gbase, voff) do { _Pragma("unroll") for (int _i = 0; _i < 2; ++_i) \
        __builtin_amdgcn_global_load_lds((const unsigned*)((const char*)(gbase) + (voff)[_i]), (LAS unsigned*)(lds + (bufoff) + ldsw + _i * 8192), 16, 0, 0); } while (0)
#define PG8_LDA(dst, b, h) do { _Pragma("unroll") for (int m = 0; m < 4; ++m) _Pragma("unroll") for (int k = 0; k < 2; ++k) dst[m][k] = *(const LAS bf16x8*)(lds + PG8_SA(b, h) + aoff + m * 2048 + k * 1024); } while (0)
#define PG8_LDB(dst, b, h) do { _Pragma("unroll") for (int n = 0; n < 2; ++n) _Pragma("unroll") for (int k = 0; k < 2; ++k) dst[n][k] = *(const LAS bf16x8*)(lds + PG8_SB(b, h) + boff + n * 2048 + k * 1024); } while (0)
#define PG8_MMA(ai, bj, At, Bt) do { __builtin_amdgcn_s_setprio(1); _Pragma("unroll") for (int m = 0; m < 4; ++m) _Pragma("unroll") for (int n = 0; n < 2; ++n) _Pragma("unroll") for (int k = 0; k < 2; ++k) \
        acc[ai][bj][m][n] = __builtin_amdgcn_mfma_f32_16x16x32_bf16(Bt[n][k], At[m][k], acc[ai][bj][m][n], 0, 0, 0); __builtin_amdgcn_s_setprio(0); } while (0)
#define PG8_WAIT_V(n) asm volatile("s_waitcnt vmcnt(" #n ")" ::: "memory")
#define PG8_WAIT_L(n) asm volatile("s_waitcnt lgkmcnt(" #n ")" ::: "memory")
#define PG8_BAR __builtin_amdgcn_s_barrier()
#define PG8_SCHED __builtin_amdgcn_sched_barrier(0)
    Unit cur, nxt; int ui = 0;
    if (!S.next(0, cur)) return;
    Acc acc;
#pragma unroll
    for (int a = 0; a < 2; ++a)
#pragma unroll
        for (int b = 0; b < 2; ++b)
#pragma unroll
            for (int m = 0; m < 4; ++m)
#pragma unroll
                for (int n = 0; n < 2; ++n) acc[a][b][m][n] = (f32x4){0.f, 0.f, 0.f, 0.f};
    bf16x8 At[4][2], B0[2][2], B1[2][2];
    const char* cA = g.a(cur); const char* cB = g.b(cur);
    if constexpr (SP2) {
        PG8_STAGE(PG8_SB(0, 0), cB, voffB); PG8_STAGE(PG8_SB(0, 1), cB + hstepB, voffB); PG8_STAGE(PG8_SA(0, 0), cA, voffA); PG8_STAGE(PG8_SA(0, 1), cA + hstepA, voffA);
        if (wr == 1) PG8_BAR;
        PG8_WAIT_V(2); PG8_BAR;
        PG8_STAGE(PG8_SB(1, 0), cB + kstep, voffB); PG8_STAGE(PG8_SA(1, 0), cA + kstep, voffA); PG8_STAGE(PG8_SB(1, 1), cB + hstepB + kstep, voffB);
        PG8_WAIT_V(6); PG8_BAR;
    } else {
        PG8_STAGE(PG8_SB(0, 0), cB, voffB); PG8_STAGE(PG8_SA(0, 0), cA, voffA); PG8_STAGE(PG8_SB(0, 1), cB + hstepB, voffB); PG8_STAGE(PG8_SA(0, 1), cA + hstepA, voffA);
        if (wr == 1) PG8_BAR;
        PG8_WAIT_V(4); PG8_BAR;
        PG8_STAGE(PG8_SB(1, 0), cB + kstep, voffB); PG8_STAGE(PG8_SA(1, 0), cA + kstep, voffA); PG8_STAGE(PG8_SB(1, 1), cB + hstepB + kstep, voffB);
        PG8_WAIT_V(6); PG8_BAR;
    }
    for (;;) {
        const bool has_next = S.next(ui + 1, nxt);
        const char* nA = has_next ? g.a(nxt) : cA; const char* nB = has_next ? g.b(nxt) : cB;
        for (int t = 0; t < nt; t += 2) {
            const bool last = (t == nt - 2);
            const char* a1 = cA + (size_t)(t + 1) * kstep;
            const char* a2 = last ? nA : cA + (size_t)(t + 2) * kstep; const char* b2 = last ? nB : cB + (size_t)(t + 2) * kstep;
            const char* a3 = a2 + kstep; const char* b3 = b2 + kstep;
            if constexpr (SP2) {
            PG8_LDB(B0, 0, 0); PG8_LDB(B1, 0, 1); PG8_SCHED; PG8_LDA(At, 0, 0); PG8_STAGE(PG8_SA(1, 1), a1 + hstepA, voffA);
            PG8_WAIT_V(8); PG8_WAIT_L(0); PG8_BAR; PG8_MMA(0, 0, At, B0); PG8_MMA(0, 1, At, B1); PG8_BAR; PG8_SCHED;
            PG8_LDA(At, 0, 1); PG8_STAGE(PG8_SB(0, 0), b2, voffB); PG8_STAGE(PG8_SB(0, 1), b2 + hstepB, voffB); PG8_STAGE(PG8_SA(0, 0), a2, voffA);
            PG8_WAIT_V(8); PG8_WAIT_L(0); PG8_BAR; PG8_MMA(1, 0, At, B0); PG8_MMA(1, 1, At, B1); PG8_BAR; PG8_SCHED;
            PG8_LDB(B0, 1, 0); PG8_LDB(B1, 1, 1); PG8_SCHED; PG8_LDA(At, 1, 0); PG8_STAGE(PG8_SA(0, 1), a2 + hstepA, voffA);
            PG8_WAIT_V(8); PG8_WAIT_L(0); PG8_BAR; PG8_MMA(0, 0, At, B0); PG8_MMA(0, 1, At, B1); PG8_BAR; PG8_SCHED;
            PG8_LDA(At, 1, 1); PG8_STAGE(PG8_SB(1, 0), b3, voffB); PG8_STAGE(PG8_SB(1, 1), b3 + hstepB, voffB); PG8_STAGE(PG8_SA(1, 0), a3, voffA);
            PG8_WAIT_V(8); PG8_WAIT_L(0); PG8_BAR; PG8_MMA(1, 0, At, B0); PG8_MMA(1, 1, At, B1); PG8_BAR; PG8_SCHED;
            } else {
            PG8_LDB(B0, 0, 0); PG8_SCHED; PG8_LDA(At, 0, 0); PG8_STAGE(PG8_SA(1, 1), a1 + hstepA, voffA);
            PG8_WAIT_L(8); PG8_BAR; PG8_WAIT_L(0); PG8_MMA(0, 0, At, B0); PG8_BAR; PG8_SCHED;
            PG8_LDB(B1, 0, 1); PG8_STAGE(PG8_SB(0, 0), b2, voffB);
            PG8_BAR; PG8_WAIT_L(0); PG8_MMA(0, 1, At, B1); PG8_BAR;
            PG8_LDA(At, 0, 1); PG8_STAGE(PG8_SA(0, 0), a2, voffA);
            PG8_BAR; PG8_WAIT_L(0); PG8_MMA(1, 0, At, B0); PG8_BAR; PG8_SCHED;
            PG8_STAGE(PG8_SB(0, 1), b2 + hstepB, voffB);
            PG8_WAIT_V(6); PG8_BAR; PG8_MMA(1, 1, At, B1); PG8_BAR;
            PG8_LDB(B0, 1, 0); PG8_SCHED; PG8_LDA(At, 1, 0); PG8_STAGE(PG8_SA(0, 1), a2 + hstepA, voffA);
            PG8_WAIT_L(8); PG8_BAR; PG8_WAIT_L(0); PG8_MMA(0, 0, At, B0); PG8_BAR; PG8_SCHED;
            PG8_LDB(B1, 1, 1); PG8_STAGE(PG8_SB(1, 0), b3, voffB);
            PG8_BAR; PG8_WAIT_L(0); PG8_MMA(0, 1, At, B1); PG8_BAR;
            PG8_LDA(At, 1, 1); PG8_STAGE(PG8_SA(1, 0), a3, voffA);
            PG8_BAR; PG8_WAIT_L(0); PG8_MMA(1, 0, At, B0); PG8_BAR; PG8_SCHED;
            PG8_STAGE(PG8_SB(1, 1), b3 + hstepB, voffB);
            PG8_WAIT_V(6); PG8_BAR; PG8_MMA(1, 1, At, B1); PG8_BAR;
            }
        }
        if constexpr (ALIGN_EPI) { if (wr == 0) PG8_BAR; }
        E(acc, cur, wr, wc, fr, fq);
        if (!E.keep(cur)) {
#pragma unroll
            for (int a = 0; a < 2; ++a)
#pragma unroll
                for (int b = 0; b < 2; ++b)
#pragma unroll
                    for (int m = 0; m < 4; ++m)
#pragma unroll
                        for (int n = 0; n < 2; ++n) acc[a][b][m][n] = (f32x4){0.f, 0.f, 0.f, 0.f};
        }
        if (!has_next) break;
        cur = nxt; cA = nA; cB = nB; ++ui;
        if constexpr (ALIGN_EPI) { if (wr == 1) PG8_BAR; }
    }
    PG8_WAIT_V(0);
    if constexpr (!ALIGN_EPI) { if (wr == 0) PG8_BAR; }
    PG8_BAR;
#undef PG8_SA
#undef PG8_SB
#undef PG8_STAGE
#undef PG8_LDA
#undef PG8_LDB
#undef PG8_MMA
#undef PG8_WAIT_V
#undef PG8_WAIT_L
#undef PG8_BAR
#undef PG8_SCHED
}
}

constexpr int NWAVES = 8;
#ifndef MK_N_LAUNCHES
#define MK_N_LAUNCHES 1
#endif
constexpr int NPHASES = 12;
constexpr int N_LAUNCHES = MK_N_LAUNCHES;
constexpr bool K_SP2 = true, K_ALIGN = true;

constexpr int CW_BAR = 4096;
constexpr int RING_OFF = 0, RING_BYTES = 131072;
constexpr int LDSCTL_OFF = RING_BYTES, MISC_OFF = LDSCTL_OFF + 320;
constexpr int LDS_BYTES = 147456;

typedef GAS unsigned gu32;
#define RLX_AGENT __ATOMIC_RELAXED, __HIP_MEMORY_SCOPE_AGENT
#define LDS_WAIT() asm volatile("s_waitcnt lgkmcnt(0)" ::: "memory")
#define VM_WAIT() asm volatile("s_waitcnt vmcnt(0)" ::: "memory")
__device__ __forceinline__ unsigned f2bf(float f) { unsigned u = __builtin_bit_cast(unsigned, f); return (u + 0x7fffu + ((u >> 16) & 1u)) >> 16; }
__device__ __forceinline__ unsigned pk2(float lo, float hi) { return f2bf(lo) | (f2bf(hi) << 16); }
using pg8::bf_lo; using pg8::bf_hi;

#define XB_TMO      128
#define XB_XCNT(j)  (256  + 64 * (j))
#define XB_XSUB(j)  (1280 + 64 * (j))
#define XB_XGEN(j)  (2304 + 64 * (j))
#define XB_TOP      3328
#define XB_TOPGEN   3392
#define XCD_BAR_WORDS 3456
#define XB_SPIN_CAP (1u << 22)
__device__ __forceinline__ unsigned xb_ld(unsigned* p)              { return __hip_atomic_load(p, __ATOMIC_RELAXED, __HIP_MEMORY_SCOPE_AGENT); }
__device__ __forceinline__ unsigned xb_add(unsigned* p, unsigned v) { return __hip_atomic_fetch_add(p, v, __ATOMIC_RELAXED, __HIP_MEMORY_SCOPE_AGENT); }
__device__ __forceinline__ unsigned xb_xcc_id() { return (unsigned)__builtin_amdgcn_s_getreg((3 << 11) | 20) & 0xFu; }
#define XB_SPIN(cond, bar) do { unsigned _sp = 0; while (cond) { __builtin_amdgcn_s_sleep(1); \
    if ((++_sp & 255u) == 0u) { if (xb_ld(&(bar)[XB_TMO])) break; if (_sp > XB_SPIN_CAP) { atomicAdd(&(bar)[XB_TMO], 1u); break; } } } } while (0)
struct XcdBarrier { unsigned* bar; unsigned x; volatile LAS unsigned* st; };
__device__ __forceinline__ XcdBarrier xcd_barrier_post(unsigned* bar, volatile LAS unsigned* st) {
    XcdBarrier b; b.bar = bar; b.x = xb_xcc_id(); b.st = st;
    if (threadIdx.x == 0) (void)xb_add(&bar[XB_XCNT(b.x)], 1u);
    return b;
}
__device__ __forceinline__ void xcd_barrier_complete(unsigned* bar, unsigned x, unsigned& nloc, unsigned& nx) {
    const unsigned G = gridDim.x * gridDim.y * gridDim.z;
    unsigned sum, cnt, mine, sp = 0u;
    for (;;) {
        sum = 0u; cnt = 0u; mine = 0u;
#pragma unroll
        for (unsigned j = 0; j < 16; ++j) { const unsigned c = xb_ld(&bar[XB_XCNT(j)]); sum += c; cnt += (c > 0u) ? 1u : 0u; mine = (j == x) ? c : mine; }
        if (sum == G) break;
        __builtin_amdgcn_s_sleep(1);
        if ((++sp & 255u) == 0u) { if (xb_ld(&bar[XB_TMO])) break; if (sp > XB_SPIN_CAP) { atomicAdd(&bar[XB_TMO], 1u); break; } }
    }
    nloc = mine > 0u ? mine : 1u; nx = cnt > 0u ? cnt : 1u;
}
__device__ __forceinline__ void xcd_barrier(const XcdBarrier& b) {
    asm volatile("s_waitcnt vmcnt(0)" ::: "memory");
    __syncthreads();
    if (threadIdx.x == 0) {
        unsigned* bar = b.bar;
        __builtin_amdgcn_s_waitcnt(0);
        unsigned nloc = b.st[0], nx = b.st[1];
        if (nloc == 0u) { xcd_barrier_complete(bar, b.x, nloc, nx); b.st[0] = nloc; b.st[1] = nx; }
        const unsigned old = xb_add(&bar[XB_XSUB(b.x)], 1u);
        const unsigned gen = old / nloc;
        if (old + 1u == (gen + 1u) * nloc) {
            __builtin_amdgcn_fence(__ATOMIC_RELEASE, "agent");
            asm volatile("s_waitcnt vmcnt(0)" ::: "memory");
            const unsigned og = xb_add(&bar[XB_TOP], 1u);
            const unsigned tg = og / nx;
            if (og + 1u == (tg + 1u) * nx) xb_add(&bar[XB_TOPGEN], 1u);
            else XB_SPIN(xb_ld(&bar[XB_TOPGEN]) == tg, bar);
            __builtin_amdgcn_fence(__ATOMIC_ACQUIRE, "agent");
            xb_add(&bar[XB_XGEN(b.x)], 1u);
            asm volatile("s_waitcnt vmcnt(0)" ::: "memory");
        } else {
            XB_SPIN(xb_ld(&bar[XB_XGEN(b.x)]) == gen, bar);
            __builtin_amdgcn_fence(__ATOMIC_ACQUIRE, "agent");
            asm volatile("s_waitcnt vmcnt(0)" ::: "memory");
        }
    }
    __syncthreads();
}

struct Args { const float* in[23]; float* out; unsigned char* ws; int ph_lo, ph_hi, li, pad; };
struct Frame {
    LAS unsigned char* lds;
    int tid, lane, wave, vcu, G;
    const float* const* in;
    float* out; unsigned char* ws;
};
__device__ __forceinline__ float wave_sum(float v) {
#pragma unroll
    for (int o = 1; o < 64; o <<= 1) v += __shfl_xor(v, o);
    return v;
}
__device__ __forceinline__ float sigm(float x) { return 1.0f / (1.0f + __expf(-x)); }
__device__ __forceinline__ float gelu_tanh(float x) { const float z = 1.5957691216f * (x + 0.044715f * x * x * x); return x / (1.0f + __expf(-z)); }

__device__ __forceinline__ void p0_transpose_item(const float* W, int K, int N, bf16_t* WT, int k0, int n0, int drow0, LAS float* scr, int lane) {
#pragma unroll 8
    for (int i = 0; i < 32; ++i) { const int kk = 2 * i + (lane >> 5); scr[kk * 33 + (lane & 31)] = W[(size_t)(k0 + kk) * N + n0 + (lane & 31)]; }
    LDS_WAIT(); asm volatile("" ::: "memory");
    const int c = lane & 7;
#pragma unroll
    for (int j = 0; j < 4; ++j) { const int n = (lane >> 3) + 8 * j; const LAS float* s = scr + (8 * c) * 33 + n;
        u32x4 o; o.x = pk2(s[0 * 33], s[1 * 33]); o.y = pk2(s[2 * 33], s[3 * 33]); o.z = pk2(s[4 * 33], s[5 * 33]); o.w = pk2(s[6 * 33], s[7 * 33]);
        *(GAS u32x4*)(WT + (size_t)(drow0 + n) * K + k0 + 8 * c) = o; }
    LDS_WAIT(); asm volatile("" ::: "memory");
}
__device__ __forceinline__ int win_drow(int n0) {
    const int seg = n0 >> 11, off = n0 & 2047;
    if (seg == 3) return 6144 + (off >> 7) * 256 + (off & 127);
    if (seg == 4) return 6144 + (off >> 7) * 256 + 128 + (off & 127);
    return n0;
}
__device__ __forceinline__ int wup_drow(int n0) {
    const int seg = n0 >= DFF ? 1 : 0, off = n0 - seg * DFF;
    return (off >> 7) * 256 + seg * 128 + (off & 127);
}
__device__ __forceinline__ void p0_prologue(Frame& F) {
    LAS float* scr = (LAS float*)(F.lds + RING_OFF + F.wave * 16384);
    const int gw = F.vcu * NWAVES + F.wave, NGW = F.G * NWAVES;
    const float* w_ada = F.in[6]; const float* w_in = F.in[10]; const float* w_out_a = F.in[15]; const float* w_out_b = F.in[16]; const float* w_o = F.in[17];
    const float* w_up = F.in[20]; const float* w_down = F.in[22];
    bf16_t* WinT = (bf16_t*)(F.ws + WS_WIN); bf16_t* WadaT = (bf16_t*)(F.ws + WS_WADA); bf16_t* WbT = (bf16_t*)(F.ws + WS_WB); bf16_t* WaT = (bf16_t*)(F.ws + WS_WA);
    bf16_t* WoT = (bf16_t*)(F.ws + WS_WO); bf16_t* WupT = (bf16_t*)(F.ws + WS_WUP); bf16_t* WdT = (bf16_t*)(F.ws + WS_WD);
    constexpr int I_ADA = (DM / 64) * (NMODC / 32), I_IN = (DM / 64) * (INW / 32), I_SQ = (DM / 64) * (DM / 32), I_UP = (DM / 64) * (2 * DFF / 32), I_DN = (DFF / 64) * (DM / 32);
    constexpr int NITEMS = I_ADA + I_IN + 3 * I_SQ + I_UP + I_DN;
    for (int it = gw; it < NITEMS; it += NGW) {
        int r = it;
        if (r < I_ADA) { const int nblk = NMODC / 32, kb = r / nblk, nb = r % nblk; p0_transpose_item(w_ada, DM, NMODC, WadaT, kb * 64, nb * 32, nb * 32, scr, F.lane); continue; } r -= I_ADA;
        if (r < I_IN) { const int nblk = INW / 32, kb = r / nblk, nb = r % nblk; p0_transpose_item(w_in, DM, INW, WinT, kb * 64, nb * 32, win_drow(nb * 32), scr, F.lane); continue; } r -= I_IN;
        if (r < I_SQ) { const int nblk = DM / 32, kb = r / nblk, nb = r % nblk; p0_transpose_item(w_out_b, DM, DM, WbT, kb * 64, nb * 32, nb * 32, scr, F.lane); continue; } r -= I_SQ;
        if (r < I_SQ) { const int nblk = DM / 32, kb = r / nblk, nb = r % nblk; p0_transpose_item(w_out_a, DM, DM, WaT, kb * 64, nb * 32, nb * 32, scr, F.lane); continue; } r -= I_SQ;
        if (r < I_SQ) { const int nblk = DM / 32, kb = r / nblk, nb = r % nblk; p0_transpose_item(w_o, DM, DM, WoT, kb * 64, nb * 32, nb * 32, scr, F.lane); continue; } r -= I_SQ;
        if (r < I_UP) { const int nblk = 2 * DFF / 32, kb = r / nblk, nb = r % nblk; p0_transpose_item(w_up, DM, 2 * DFF, WupT, kb * 64, nb * 32, wup_drow(nb * 32), scr, F.lane); continue; } r -= I_UP;
        { const int nblk = DM / 32, kb = r / nblk, nb = r % nblk; p0_transpose_item(w_down, DFF, DM, WdT, kb * 64, nb * 32, nb * 32, scr, F.lane); }
    }
    bf16_t* S = (bf16_t*)(F.ws + WS_S);
    const float* c_p = F.in[2]; const float* c_s = F.in[3];
    for (int r = gw; r < 256; r += NGW) {
        const float* src = r < NB ? c_p + (size_t)r * DM : c_s + (size_t)(r - NB) * DM;
#pragma unroll
        for (int j = 0; j < 8; ++j) { const int c = 4 * F.lane + 256 * j; u32x2 o = {0u, 0u};
            if (r < NBIDX) { const f32x4 v = *(const f32x4*)(src + c); o.x = pk2(v[0] * sigm(v[0]), v[1] * sigm(v[1])); o.y = pk2(v[2] * sigm(v[2]), v[3] * sigm(v[3])); }
            *(u32x2*)(S + (size_t)r * DM + c) = o; }
    }
}

__device__ __forceinline__ void p_h1(Frame& F) {
    const int gw = F.vcu * NWAVES + F.wave, NGW = F.G * NWAVES;
    const float* g_pre = F.in[8]; const float* MOD = (const float*)(F.ws + WS_MOD); bf16_t* H1 = (bf16_t*)(F.ws + WS_H1);
    for (int r = gw; r < M; r += NGW) {
        const float* xrow = r < MP ? F.in[0] + (size_t)r * DM : F.in[1] + (size_t)(r - MP) * DM;
        const int bidx = r < MP ? r / SEQ : NB + (r - MP) / DS;
        const float* mod = MOD + (size_t)bidx * NMODC;
        f32x4 v[8]; float s = 0.f;
#pragma unroll
        for (int j = 0; j < 8; ++j) { v[j] = *(const f32x4*)(xrow + 4 * F.lane + 256 * j); s += (v[j][0] * v[j][0] + v[j][1] * v[j][1]) + (v[j][2] * v[j][2] + v[j][3] * v[j][3]); }
        const float rstd = 1.0f / sqrtf(wave_sum(s) * (1.0f / DM) + EPS);
#pragma unroll
        for (int j = 0; j < 8; ++j) { const int c = 4 * F.lane + 256 * j;
            const f32x4 g = *(const f32x4*)(g_pre + c), sh = *(const f32x4*)(mod + c), sc = *(const f32x4*)(mod + DM + c);
            const f32x4 h = v[j] * rstd * g * (sc + 1.0f) + sh;
            u32x2 o; o.x = pk2(h[0], h[1]); o.y = pk2(h[2], h[3]);
            *(u32x2*)(H1 + (size_t)r * DM + c) = o; }
    }
}

template <int ACT>
__device__ __forceinline__ void conv_gate(Frame& F, const bf16_t* A, const bf16_t* B, bf16_t* O, const int C, const float* w, const float* state, float* out_p, float* out_s) {
    const int C8 = C / 8, NRB = M / 16, total = NRB * C8;
    const int gtid = F.vcu * (NWAVES * 64) + F.tid, NT = F.G * NWAVES * 64;
    for (int idx = gtid; idx < total; idx += NT) {
        const int c8 = idx % C8, rb = idx / C8, c = c8 * 8, r0 = rb * 16;
        float w0[8], w1[8], w2[8];
#pragma unroll
        for (int h = 0; h < 2; ++h) { const f32x4 a = *(const f32x4*)(w + c + 4 * h), b = *(const f32x4*)(w + C + c + 4 * h), d = *(const f32x4*)(w + 2 * C + c + 4 * h);
#pragma unroll
            for (int i = 0; i < 4; ++i) { w0[4 * h + i] = a[i]; w1[4 * h + i] = b[i]; w2[4 * h + i] = d[i]; } }
        float p2[8], p1[8];
        const bool prompt = r0 < MP;
        const int t0 = prompt ? (r0 % SEQ) : 0, bb = prompt ? (r0 / SEQ) : 0;
        if (prompt) {
            if (t0 == 0) {
#pragma unroll
                for (int i = 0; i < 8; ++i) { p2[i] = 0.f; p1[i] = 0.f; }
            } else {
                const u32x4 q2 = *(const u32x4*)(A + (size_t)(r0 - 2) * C + c), q1 = *(const u32x4*)(A + (size_t)(r0 - 1) * C + c);
                p2[0] = bf_lo(q2.x); p2[1] = bf_hi(q2.x); p2[2] = bf_lo(q2.y); p2[3] = bf_hi(q2.y); p2[4] = bf_lo(q2.z); p2[5] = bf_hi(q2.z); p2[6] = bf_lo(q2.w); p2[7] = bf_hi(q2.w);
                p1[0] = bf_lo(q1.x); p1[1] = bf_hi(q1.x); p1[2] = bf_lo(q1.y); p1[3] = bf_hi(q1.y); p1[4] = bf_lo(q1.z); p1[5] = bf_hi(q1.z); p1[6] = bf_lo(q1.w); p1[7] = bf_hi(q1.w);
            }
        }
#pragma unroll 4
        for (int i = 0; i < 16; ++i) {
            const int r = r0 + i;
            if (!prompt && (i & 3) == 0) {
                const int sb = (r - MP) >> 2;
#pragma unroll
                for (int h = 0; h < 2; ++h) { const f32x4 s2 = *(const f32x4*)(state + ((size_t)sb * 2 + 0) * C + c + 4 * h), s1 = *(const f32x4*)(state + ((size_t)sb * 2 + 1) * C + c + 4 * h);
#pragma unroll
                    for (int k = 0; k < 4; ++k) { p2[4 * h + k] = s2[k]; p1[4 * h + k] = s1[k]; } }
            }
            const u32x4 qa = *(const u32x4*)(A + (size_t)r * C + c), qb = *(const u32x4*)(B + (size_t)r * C + c);
            float a[8], b[8], o[8];
            a[0] = bf_lo(qa.x); a[1] = bf_hi(qa.x); a[2] = bf_lo(qa.y); a[3] = bf_hi(qa.y); a[4] = bf_lo(qa.z); a[5] = bf_hi(qa.z); a[6] = bf_lo(qa.w); a[7] = bf_hi(qa.w);
            b[0] = bf_lo(qb.x); b[1] = bf_hi(qb.x); b[2] = bf_lo(qb.y); b[3] = bf_hi(qb.y); b[4] = bf_lo(qb.z); b[5] = bf_hi(qb.z); b[6] = bf_lo(qb.w); b[7] = bf_hi(qb.w);
#pragma unroll
            for (int k = 0; k < 8; ++k) { const float y = w0[k] * p2[k] + w1[k] * p1[k] + w2[k] * a[k]; o[k] = (ACT == 1 ? gelu_tanh(y) : y) * b[k]; p2[k] = p1[k]; p1[k] = a[k]; }
            u32x4 ov; ov.x = pk2(o[0], o[1]); ov.y = pk2(o[2], o[3]); ov.z = pk2(o[4], o[5]); ov.w = pk2(o[6], o[7]);
            *(u32x4*)(O + (size_t)r * C + c) = ov;
            float* so = nullptr;
            if (prompt) { const int t = t0 + i; if (t >= SEQ - 2) so = out_p + ((size_t)bb * 2 + (t - (SEQ - 2))) * C + c; }
            else { const int tt = i & 3; if (tt >= 2) so = out_s + ((size_t)((r - MP) >> 2) * 2 + (tt - 2)) * C + c; }
            if (so) { *(f32x4*)so = (f32x4){a[0], a[1], a[2], a[3]}; *(f32x4*)(so + 4) = (f32x4){a[4], a[5], a[6], a[7]}; }
        }
    }
}

__device__ __forceinline__ void p_gate(Frame& F) {
    const bf16_t* U = (const bf16_t*)(F.ws + WS_U); const bf16_t* V = (const bf16_t*)(F.ws + WS_V); const bf16_t* BG = (const bf16_t*)(F.ws + WS_BG); const bf16_t* P = (const bf16_t*)(F.ws + WS_P);
    bf16_t* YA = (bf16_t*)(F.ws + WS_YA); bf16_t* YB = (bf16_t*)(F.ws + WS_YB); const float* VSS = (const float*)(F.ws + WS_VSS);
    const float* g_v = F.in[11]; const float* w_s = F.in[12]; const float* b_s = F.in[13];
    LAS float* rs = (LAS float*)(F.lds);
    LAS bf16_t* VT = (LAS bf16_t*)(F.lds + 1024);
    constexpr int VTS = 136;
    const int tid = F.tid, lane = F.lane, w = F.wave;
    for (int it = F.vcu; it < (MP / 128) * 16; it += F.G) {
        const int ch = it >> 4, g = it & 15, r0 = ch * 128;
        if (tid < 128) { const f32x4* p = (const f32x4*)(VSS + (size_t)(r0 + tid) * 32); float s = 0.f;
#pragma unroll
            for (int q = 0; q < 8; ++q) { const f32x4 a = p[q]; s += (a[0] + a[1]) + (a[2] + a[3]); }
            rs[tid] = 1.0f / sqrtf(s * (1.0f / DM) + EPS); }
        __syncthreads();
        { const int s_ = tid >> 2, cq = (tid & 3) * 32; const float rsd = rs[s_];
#pragma unroll
          for (int q = 0; q < 4; ++q) { const int c = cq + 8 * q;
              const u32x4 raw = *(const u32x4*)(V + (size_t)(r0 + s_) * DM + g * 128 + c);
              const f32x4 g0 = *(const f32x4*)(g_v + g * 128 + c), g1 = *(const f32x4*)(g_v + g * 128 + c + 4);
              float x[8] = {bf_lo(raw.x), bf_hi(raw.x), bf_lo(raw.y), bf_hi(raw.y), bf_lo(raw.z), bf_hi(raw.z), bf_lo(raw.w), bf_hi(raw.w)};
#pragma unroll
              for (int j = 0; j < 8; ++j) { const float gg = j < 4 ? g0[j & 3] : g1[j & 3]; VT[(c + j) * VTS + s_] = (bf16_t)f2bf(x[j] * rsd * gg); } } }
        __syncthreads();
        f32x4 acc[8];
#pragma unroll
        for (int cb = 0; cb < 8; ++cb) acc[cb] = (f32x4){0.f, 0.f, 0.f, 0.f};
        const int t = 16 * w + (lane & 15);
        for (int kk = 0; kk <= (w >> 1); ++kk) {
            const int s0 = 32 * kk + 8 * (lane >> 4);
            const float* wp = w_s + ((size_t)g * 128 + t) * 128 + s0;
            const f32x4 wa = *(const f32x4*)wp, wb = *(const f32x4*)(wp + 4);
            float wv[8] = {wa[0], wa[1], wa[2], wa[3], wb[0], wb[1], wb[2], wb[3]};
#pragma unroll
            for (int j = 0; j < 8; ++j) if (s0 + j > t) wv[j] = 0.f;
            u32x4 bw; bw.x = pk2(wv[0], wv[1]); bw.y = pk2(wv[2], wv[3]); bw.z = pk2(wv[4], wv[5]); bw.w = pk2(wv[6], wv[7]);
            const bf16x8 bfrag = __builtin_bit_cast(bf16x8, bw);
#pragma unroll
            for (int cb = 0; cb < 8; ++cb) {
                const bf16x8 afrag = *(const LAS bf16x8*)(VT + (16 * cb + (lane & 15)) * VTS + s0);
                acc[cb] = __builtin_amdgcn_mfma_f32_16x16x32_bf16(afrag, bfrag, acc[cb], 0, 0, 0);
            }
        }
        { const int row = r0 + t; const float bsv = b_s[g * 128 + t];
#pragma unroll
          for (int cb = 0; cb < 8; ++cb) { const int col = g * 128 + 16 * cb + 4 * (lane >> 4);
              const u32x2 uu = *(const u32x2*)(U + (size_t)row * DM + col);
              u32x2 o; o.x = pk2(bf_lo(uu.x) * (acc[cb][0] + bsv), bf_hi(uu.x) * (acc[cb][1] + bsv)); o.y = pk2(bf_lo(uu.y) * (acc[cb][2] + bsv), bf_hi(uu.y) * (acc[cb][3] + bsv));
              *(u32x2*)(YA + (size_t)row * DM + col) = o; } }
        __syncthreads();
    }
    conv_gate<0>(F, P, BG, YB, DM, F.in[14], F.in[4], F.out + O_CBP, F.out + O_CBS);
    for (int it = F.vcu; it < DB / 2; it += F.G) {
        const int sb = it * 2 + (tid >> 8), c = (tid & 255) * 8, rb = MP + sb * 4, g = c >> 7;
        if (tid < 8) { const int row = MP + it * 8 + tid; const f32x4* p = (const f32x4*)(VSS + (size_t)row * 32); float s = 0.f;
#pragma unroll
            for (int q = 0; q < 8; ++q) { const f32x4 a = p[q]; s += (a[0] + a[1]) + (a[2] + a[3]); }
            rs[tid] = 1.0f / sqrtf(s * (1.0f / DM) + EPS); }
        __syncthreads();
        float vn[4][8];
        const f32x4 g0 = *(const f32x4*)(g_v + c), g1 = *(const f32x4*)(g_v + c + 4);
#pragma unroll
        for (int tt = 0; tt < 4; ++tt) { const float rsd = rs[(tid >> 8) * 4 + tt];
            const u32x4 raw = *(const u32x4*)(V + (size_t)(rb + tt) * DM + c);
            float x[8] = {bf_lo(raw.x), bf_hi(raw.x), bf_lo(raw.y), bf_hi(raw.y), bf_lo(raw.z), bf_hi(raw.z), bf_lo(raw.w), bf_hi(raw.w)};
#pragma unroll
            for (int j = 0; j < 8; ++j) vn[tt][j] = x[j] * rsd * (j < 4 ? g0[j & 3] : g1[j & 3]);
            float* cv = F.out + O_CV + ((size_t)sb * 4 + tt) * DM + c;
            *(f32x4*)cv = (f32x4){vn[tt][0], vn[tt][1], vn[tt][2], vn[tt][3]}; *(f32x4*)(cv + 4) = (f32x4){vn[tt][4], vn[tt][5], vn[tt][6], vn[tt][7]}; }
#pragma unroll
        for (int tt = 0; tt < 4; ++tt) {
            float sacc[8]; const float bsv = b_s[g * 128 + tt];
#pragma unroll
            for (int j = 0; j < 8; ++j) sacc[j] = bsv;
#pragma unroll
            for (int ss = 0; ss < 4; ++ss) if (ss <= tt) { const float ww = w_s[((size_t)g * 128 + tt) * 128 + ss];
#pragma unroll
                for (int j = 0; j < 8; ++j) sacc[j] += ww * vn[ss][j]; }
            const u32x4 uu = *(const u32x4*)(U + (size_t)(rb + tt) * DM + c);
            u32x4 o; o.x = pk2(bf_lo(uu.x) * sacc[0], bf_hi(uu.x) * sacc[1]); o.y = pk2(bf_lo(uu.y) * sacc[2], bf_hi(uu.y) * sacc[3]);
            o.z = pk2(bf_lo(uu.z) * sacc[4], bf_hi(uu.z) * sacc[5]); o.w = pk2(bf_lo(uu.w) * sacc[6], bf_hi(uu.w) * sacc[7]);
            *(u32x4*)(YA + (size_t)(rb + tt) * DM + c) = o; }
        __syncthreads();
    }
}

__device__ __forceinline__ void p_x1h2(Frame& F) {
    const int gw = F.vcu * NWAVES + F.wave, NGW = F.G * NWAVES;
    const bf16_t* T = (const bf16_t*)(F.ws + WS_T); bf16_t* H2 = (bf16_t*)(F.ws + WS_H2); const float* MOD = (const float*)(F.ws + WS_MOD);
    const float* g_post = F.in[9]; const float* g_pre2 = F.in[18];
    for (int r = gw; r < M; r += NGW) {
        const float* xrow = r < MP ? F.in[0] + (size_t)r * DM : F.in[1] + (size_t)(r - MP) * DM;
        const int bidx = r < MP ? r / SEQ : NB + (r - MP) / DS;
        const float* mod = MOD + (size_t)bidx * NMODC;
        float tv[4][8]; float s = 0.f;
#pragma unroll
        for (int j = 0; j < 4; ++j) { const u32x4 raw = *(const u32x4*)(T + (size_t)r * DM + 8 * F.lane + 512 * j);
            tv[j][0] = bf_lo(raw.x); tv[j][1] = bf_hi(raw.x); tv[j][2] = bf_lo(raw.y); tv[j][3] = bf_hi(raw.y); tv[j][4] = bf_lo(raw.z); tv[j][5] = bf_hi(raw.z); tv[j][6] = bf_lo(raw.w); tv[j][7] = bf_hi(raw.w);
#pragma unroll
            for (int k = 0; k < 8; ++k) s += tv[j][k] * tv[j][k]; }
        const float rstdT = 1.0f / sqrtf(wave_sum(s) * (1.0f / DM) + EPS);
        float s1 = 0.f;
#pragma unroll
        for (int j = 0; j < 4; ++j) { const int c = 8 * F.lane + 512 * j;
#pragma unroll
            for (int h = 0; h < 2; ++h) { const f32x4 xv = *(const f32x4*)(xrow + c + 4 * h), gp = *(const f32x4*)(g_post + c + 4 * h), gt = *(const f32x4*)(mod + 2 * DM + c + 4 * h);
                f32x4 x1;
#pragma unroll
                for (int k = 0; k < 4; ++k) { x1[k] = xv[k] + gt[k] * (tv[j][4 * h + k] * rstdT * gp[k]); tv[j][4 * h + k] = x1[k]; s1 += x1[k] * x1[k]; }
                *(f32x4*)(F.out + O_Y + (size_t)r * DM + c + 4 * h) = x1; } }
        const float rstd1 = 1.0f / sqrtf(wave_sum(s1) * (1.0f / DM) + EPS);
#pragma unroll
        for (int j = 0; j < 4; ++j) { const int c = 8 * F.lane + 512 * j; float h2[8];
#pragma unroll
            for (int h = 0; h < 2; ++h) { const f32x4 gp = *(const f32x4*)(g_pre2 + c + 4 * h), sh = *(const f32x4*)(mod + 3 * DM + c + 4 * h), sc = *(const f32x4*)(mod + 4 * DM + c + 4 * h);
#pragma unroll
                for (int k = 0; k < 4; ++k) h2[4 * h + k] = tv[j][4 * h + k] * rstd1 * gp[k] * (1.0f + sc[k]) + sh[k]; }
            u32x4 o; o.x = pk2(h2[0], h2[1]); o.y = pk2(h2[2], h2[3]); o.z = pk2(h2[4], h2[5]); o.w = pk2(h2[6], h2[7]);
            *(u32x4*)(H2 + (size_t)r * DM + c) = o; }
    }
}

__device__ __forceinline__ void p_final(Frame& F) {
    const int gw = F.vcu * NWAVES + F.wave, NGW = F.G * NWAVES;
    const bf16_t* Fb = (const bf16_t*)(F.ws + WS_F); const float* MOD = (const float*)(F.ws + WS_MOD); const float* g_post = F.in[19];
    for (int r = gw; r < M; r += NGW) {
        const int bidx = r < MP ? r / SEQ : NB + (r - MP) / DS;
        const float* mod = MOD + (size_t)bidx * NMODC;
        float tv[4][8]; float s = 0.f;
#pragma unroll
        for (int j = 0; j < 4; ++j) { const u32x4 raw = *(const u32x4*)(Fb + (size_t)r * DM + 8 * F.lane + 512 * j);
            tv[j][0] = bf_lo(raw.x); tv[j][1] = bf_hi(raw.x); tv[j][2] = bf_lo(raw.y); tv[j][3] = bf_hi(raw.y); tv[j][4] = bf_lo(raw.z); tv[j][5] = bf_hi(raw.z); tv[j][6] = bf_lo(raw.w); tv[j][7] = bf_hi(raw.w);
#pragma unroll
            for (int k = 0; k < 8; ++k) s += tv[j][k] * tv[j][k]; }
        const float rstd = 1.0f / sqrtf(wave_sum(s) * (1.0f / DM) + EPS);
#pragma unroll
        for (int j = 0; j < 4; ++j) { const int c = 8 * F.lane + 512 * j;
#pragma unroll
            for (int h = 0; h < 2; ++h) { float* yp = F.out + O_Y + (size_t)r * DM + c + 4 * h;
                const f32x4 xv = *(const f32x4*)yp, gp = *(const f32x4*)(g_post + c + 4 * h), gt = *(const f32x4*)(mod + 5 * DM + c + 4 * h);
                f32x4 y;
#pragma unroll
                for (int k = 0; k < 4; ++k) y[k] = xv[k] + gt[k] * (tv[j][4 * h + k] * rstd * gp[k]);
                *(f32x4*)yp = y; } }
    }
}

__global__ void __launch_bounds__(NWAVES * 64, 2) fwd_megakernel(Args args) {
    extern __shared__ __attribute__((aligned(16))) unsigned char lds[];
    Frame F;
    F.lds = (LAS unsigned char*)lds;
    F.tid = threadIdx.x; F.lane = F.tid & 63; F.wave = __builtin_amdgcn_readfirstlane(F.tid >> 6);
    F.G = gridDim.x; { const int bx = blockIdx.x; F.vcu = (F.G % 8 == 0) ? (bx % 8) * (F.G / 8) + bx / 8 : bx; }
    F.in = args.in; F.out = args.out; F.ws = args.ws;
    unsigned char* ws = args.ws;
    volatile LAS unsigned* MISC = (volatile LAS unsigned*)(F.lds + MISC_OFF);
    for (int u = F.tid; u < (LDS_BYTES - LDSCTL_OFF) / 4; u += NWAVES * 64) ((LAS unsigned*)(F.lds + LDSCTL_OFF))[u] = 0u;
    __syncthreads();
    XcdBarrier bar; bar.bar = (unsigned*)(ws + WS_CTL) + CW_BAR; bar.x = 0; bar.st = nullptr;
    if (N_LAUNCHES == 1) bar = xcd_barrier_post((unsigned*)(ws + WS_CTL) + CW_BAR, MISC + 8);
    const int lo = args.ph_lo, hi = args.ph_hi;
#define IN(k) (lo <= (k) && (k) < hi)
#define SEAM(k) do { if (IN(k) && IN((k) + 1)) xcd_barrier(bar); } while (0)
    using namespace pg8;
    LAS unsigned char* ring = F.lds + RING_OFF;
    const int cid = (int)blockIdx.x;

    if (IN(0)) { p0_prologue(F); } SEAM(0);
    if (IN(1)) {
        Ptrs g{(const bf16_t*)(ws + WS_S), (const bf16_t*)(ws + WS_WADA), nullptr, nullptr, DM, DM};
        StaticOrder S; S.init(1, NMODC / 256, F.G, cid, 1);
        EpiF32 E{(float*)(ws + WS_MOD), NMODC, F.in[7]};
        gemm_phase<EpiF32, StaticOrder, false, K_SP2>(ring, g, DM, S, E);
    } SEAM(1);
    if (IN(2)) { p_h1(F); } SEAM(2);
    if (IN(3)) {
        Ptrs g{(const bf16_t*)(ws + WS_H1), (const bf16_t*)(ws + WS_WIN), nullptr, nullptr, DM, DM};
        StaticOrder S; S.init(M / 256, INW / 256, F.G, cid, 1);
        EpiIn E{(bf16_t*)(ws + WS_U), (bf16_t*)(ws + WS_V), (bf16_t*)(ws + WS_BG), (bf16_t*)(ws + WS_P), (bf16_t*)(ws + WS_SGA), (bf16_t*)(ws + WS_SGB), (float*)(ws + WS_VSS)};
        gemm_phase<EpiIn, StaticOrder, K_ALIGN, K_SP2>(ring, g, DM, S, E);
    } SEAM(3);
    if (IN(4)) { p_gate(F); } SEAM(4);
    if (IN(5)) {
        Ptrs g{(const bf16_t*)(ws + WS_YB), (const bf16_t*)(ws + WS_WB), (const bf16_t*)(ws + WS_YA), (const bf16_t*)(ws + WS_WA), DM, DM};
        StaticOrder S; S.init(M / 256, DM / 256, F.G, cid, 2);
        EpiOut E{(const bf16_t*)(ws + WS_SGA), (const bf16_t*)(ws + WS_SGB), (bf16_t*)(ws + WS_MERGED)};
        gemm_phase<EpiOut, StaticOrder, K_ALIGN, K_SP2>(ring, g, DM, S, E);
    } SEAM(5);
    if (IN(6)) {
        Ptrs g{(const bf16_t*)(ws + WS_MERGED), (const bf16_t*)(ws + WS_WO), nullptr, nullptr, DM, DM};
        StaticOrder S; S.init(M / 256, DM / 256, F.G, cid, 1);
        EpiBf16 E{(bf16_t*)(ws + WS_T), DM};
        gemm_phase<EpiBf16, StaticOrder, K_ALIGN, K_SP2>(ring, g, DM, S, E);
    } SEAM(6);
    if (IN(7)) { p_x1h2(F); } SEAM(7);
    if (IN(8)) {
        Ptrs g{(const bf16_t*)(ws + WS_H2), (const bf16_t*)(ws + WS_WUP), nullptr, nullptr, DM, DM};
        StaticOrder S; S.init(M / 256, 2 * DFF / 256, F.G, cid, 1);
        EpiUp E{(bf16_t*)(ws + WS_AUP), (bf16_t*)(ws + WS_BUP)};
        gemm_phase<EpiUp, StaticOrder, K_ALIGN, K_SP2>(ring, g, DM, S, E);
    } SEAM(8);
    if (IN(9)) { conv_gate<1>(F, (const bf16_t*)(ws + WS_AUP), (const bf16_t*)(ws + WS_BUP), (bf16_t*)(ws + WS_G), DFF, F.in[21], F.in[5], F.out + O_CFP, F.out + O_CFS); } SEAM(9);
    if (IN(10)) {
        Ptrs g{(const bf16_t*)(ws + WS_G), (const bf16_t*)(ws + WS_WD), nullptr, nullptr, DFF, DFF};
        StaticOrder S; S.init(M / 256, DM / 256, F.G, cid, 1);
        EpiBf16 E{(bf16_t*)(ws + WS_F), DM};
        gemm_phase<EpiBf16, StaticOrder, K_ALIGN, K_SP2>(ring, g, DFF, S, E);
    } SEAM(10);
    if (IN(11)) { p_final(F); }
#undef IN
#undef SEAM
}

extern "C" void kernel_launch(void* const* d_in, const int* in_sizes, int n_in, void* d_out, int out_size, void* d_ws, size_t ws_size, hipStream_t stream) {
    static int grid = 0;
    if (grid == 0) {
        if (n_in != 23 || out_size != (int)O_END || ws_size < WS_END) { fprintf(stderr, "kernel_launch: unexpected shapes: n_in %d out %d ws %zu (need %zu)\n", n_in, out_size, ws_size, (size_t)WS_END); grid = -1; return; }
        int dev = 0, cus = 0, per_cu = 0;
        if (hipGetDevice(&dev) != hipSuccess || hipDeviceGetAttribute(&cus, hipDeviceAttributeMultiprocessorCount, dev) != hipSuccess) { grid = -1; return; }
        if (hipFuncSetAttribute((const void*)fwd_megakernel, hipFuncAttributeMaxDynamicSharedMemorySize, LDS_BYTES) != hipSuccess) { fprintf(stderr, "kernel_launch: hipFuncSetAttribute failed\n"); grid = -1; return; }
        if (hipOccupancyMaxActiveBlocksPerMultiprocessor(&per_cu, (const void*)fwd_megakernel, NWAVES * 64, LDS_BYTES) != hipSuccess || per_cu < 1) { fprintf(stderr, "kernel_launch: occupancy query says %d blocks per CU\n", per_cu); (void)hipGetLastError(); grid = -1; return; }
        grid = cus;
    }
    if (grid < 0) return;
    (void)hipMemsetAsync((char*)d_ws + WS_CTL, 0, CTL_ZERO_BYTES, stream);
    Args a{};
    for (int i = 0; i < 23; ++i) a.in[i] = (const float*)d_in[i];
    a.out = (float*)d_out; a.ws = (unsigned char*)d_ws;
    if (N_LAUNCHES == 1) {
        a.ph_lo = 0; a.ph_hi = NPHASES; a.li = 0;
        hipLaunchKernelGGL(fwd_megakernel, dim3(grid), dim3(NWAVES * 64), LDS_BYTES, stream, a);
    } else {
        for (int li = 0; li < NPHASES; ++li) { a.ph_lo = li; a.ph_hi = li + 1; a.li = li;
            hipLaunchKernelGGL(fwd_megakernel, dim3(grid), dim3(NWAVES * 64), LDS_BYTES, stream, a); }
    }
    const hipError_t le = hipPeekAtLastError();
    if (le != hipSuccess) fprintf(stderr, "kernel_launch: launch failed: %s\n", hipGetErrorName(le));
}
```

```cpp
#include <hip/hip_runtime.h>
#include <cstdio>
#include <cstdint>

#define LAS __attribute__((address_space(3)))
#define GAS __attribute__((address_space(1)))
typedef unsigned short bf16_t;
typedef short bf16x8 __attribute__((ext_vector_type(8)));
typedef float f32x4 __attribute__((ext_vector_type(4)));
typedef float f32x2 __attribute__((ext_vector_type(2)));
typedef unsigned u32x4 __attribute__((ext_vector_type(4)));
typedef unsigned u32x2 __attribute__((ext_vector_type(2)));

constexpr int DM = 2048, NB = 4, SEQ = 2048, DB = 128, DS = 4, DFF = 5632, INW = 14336, NMODC = 6 * DM;
constexpr int MP = NB * SEQ, MS = DB * DS, M = MP + MS;
constexpr int NBIDX = NB + DB;
constexpr float EPS = 1e-6f;

constexpr size_t MiB = 1u << 20;
constexpr size_t WS_CTL = 0, CTL_ZERO_BYTES = 1 * MiB;
constexpr size_t WS_S = 1 * MiB;
constexpr size_t WS_MOD = 2 * MiB;
constexpr size_t WS_VSS = 14 * MiB;
constexpr size_t WS_WIN = 16 * MiB;
constexpr size_t WS_WB = 72 * MiB, WS_WA = 80 * MiB, WS_WO = 88 * MiB;
constexpr size_t WS_WUP = 96 * MiB;
constexpr size_t WS_WD = 140 * MiB;
constexpr size_t WS_R1 = 162 * MiB;
constexpr size_t SLOT = 34 * MiB;
constexpr size_t WS_H1 = WS_R1, WS_YA = WS_R1, WS_H2 = WS_R1, WS_YB = WS_R1 + SLOT, WS_WADA = WS_R1;
constexpr size_t WS_R2 = 230 * MiB;
constexpr size_t WS_U = WS_R2, WS_V = WS_R2 + SLOT, WS_BG = WS_R2 + 2 * SLOT, WS_P = WS_R2 + 3 * SLOT, WS_SGA = WS_R2 + 4 * SLOT, WS_SGB = WS_R2 + 5 * SLOT;
constexpr size_t WS_MERGED = WS_R2, WS_T = WS_R2 + SLOT, WS_F = WS_R2;
constexpr size_t WS_AUP = WS_R2, WS_BUP = WS_R2 + 94 * MiB;
constexpr size_t WS_G = 16 * MiB;
constexpr size_t WS_END = 434 * MiB;
static_assert(WS_G + (size_t)M * DFF * 2 <= WS_WD, "G overlay must stay clear of WdT");
static_assert(WS_BUP + (size_t)M * DFF * 2 <= WS_END, "ws map");
static_assert((size_t)M * DM * 2 == SLOT, "slot size");

constexpr size_t O_Y = 0, O_CBP = (size_t)M * DM, O_CBS = O_CBP + (size_t)NB * 2 * DM, O_CFP = O_CBS + (size_t)DB * 2 * DM,
                 O_CFS = O_CFP + (size_t)NB * 2 * DFF, O_CV = O_CFS + (size_t)DB * 2 * DFF, O_END = O_CV + (size_t)MS * DM;

namespace pg8 {
constexpr int BM = 256, BK = 64, HALF = 128, HTB = HALF * BK * 2, STAGE_BYTES = 8 * HTB, NXCD = 8, WGM = 8;
__host__ __device__ __forceinline__ int lds_byte(int r, int c) { const int st = (r >> 4) * 2 + (c >> 5), rr = r & 15, cc = c & 31, ob = rr * 64 + cc * 2; return st * 1024 + (ob ^ (((ob >> 9) & 1) << 5)); }
__host__ __device__ __forceinline__ void stage_rc(int b, int& R, int& C) { const int st = b / 1024, sb = b % 1024, swz = sb ^ (((sb >> 9) & 1) << 5); R = (st >> 1) * 16 + swz / 64; C = (st & 1) * 32 + (swz % 64) / 2; }
__host__ __device__ __forceinline__ int perm32(int rho) { const int n = rho >> 4, i = rho & 15; return 8 * (i >> 2) + 4 * n + (i & 3); }

struct Unit { int pm, pn, part; };

struct StaticOrder {
    int nM, nN, nwg, G, c, parts;
    __device__ void init(int nM_, int nN_, int G_, int c_, int parts_) { nM = nM_; nN = nN_; nwg = nM * nN; G = G_; c = c_; parts = parts_; }
    __device__ bool next(int i, Unit& u) const {
        const int ti = (parts == 2) ? (i >> 1) : i; u.part = (parts == 2) ? (i & 1) : 0;
        const long L = (long)ti * G + c; if (L >= nwg) return false;
        int wgid = (int)L; { const int q = nwg / NXCD, r = nwg % NXCD, xcd = wgid % NXCD, off = wgid / NXCD; wgid = (xcd < r ? xcd * (q + 1) : r * (q + 1) + (xcd - r) * q) + off; }
        const int nig = WGM * nN, gid = wgid / nig, fm = gid * WGM, gsz = (nM - fm) < WGM ? (nM - fm) : WGM;
        u.pm = fm + ((wgid % nig) % gsz); u.pn = (wgid % nig) / gsz; return true;
    }
};

struct Ptrs {
    const bf16_t* A0; const bf16_t* B0; const bf16_t* A1; const bf16_t* B1; int lda, ldb;
    __device__ __forceinline__ const char* a(const Unit& u) const { return (const char*)((u.part ? A1 : A0) + (size_t)u.pm * BM * lda); }
    __device__ __forceinline__ const char* b(const Unit& u) const { return (const char*)((u.part ? B1 : B0) + (size_t)u.pn * BM * ldb); }
};

__device__ __forceinline__ unsigned cvt_pk_bf16(float lo, float hi) { unsigned r; asm volatile("v_cvt_pk_bf16_f32 %0, %1, %2" : "=v"(r) : "v"(lo), "v"(hi)); return r; }
__device__ __forceinline__ float bf_lo(unsigned w) { return __builtin_bit_cast(float, w << 16); }
__device__ __forceinline__ float bf_hi(unsigned w) { return __builtin_bit_cast(float, w & 0xffff0000u); }
__device__ __forceinline__ float sigmoidf_(float x) { return __builtin_amdgcn_rcpf(1.0f + __builtin_amdgcn_exp2f(-1.4426950409f * x)); }

typedef f32x4 Acc[2][2][4][2];

__device__ __forceinline__ u32x4 pack8(const f32x4& v0, const f32x4& v1) { u32x4 w; w.x = cvt_pk_bf16(v0[0], v0[1]); w.y = cvt_pk_bf16(v0[2], v0[3]); w.z = cvt_pk_bf16(v1[0], v1[1]); w.w = cvt_pk_bf16(v1[2], v1[3]); return w; }

struct EpiF32 {
    static constexpr bool PERM = false;
    float* C; int ldc; const float* bias;
    __device__ __forceinline__ bool keep(const Unit&) const { return false; }
    __device__ __forceinline__ void operator()(Acc& acc, const Unit& u, int wr, int wc, int fr, int fq) const {
        const int row0 = u.pm * BM + wr * 64 + fr, col0 = u.pn * BM + wc * 32 + 4 * fq;
        f32x4 bv[2][2];
#pragma unroll
        for (int bj = 0; bj < 2; ++bj)
#pragma unroll
            for (int n = 0; n < 2; ++n) bv[bj][n] = *(const f32x4*)(bias + col0 + bj * HALF + n * 16);
#pragma unroll
        for (int ai = 0; ai < 2; ++ai)
#pragma unroll
            for (int m = 0; m < 4; ++m) { float* rowp = C + (size_t)(row0 + ai * HALF + m * 16) * ldc + col0;
#pragma unroll
                for (int bj = 0; bj < 2; ++bj)
#pragma unroll
                    for (int n = 0; n < 2; ++n) *(f32x4*)(rowp + bj * HALF + n * 16) = acc[ai][bj][m][n] + bv[bj][n]; }
    }
};

struct EpiBf16 {
    static constexpr bool PERM = true;
    bf16_t* O; int ldc;
    __device__ __forceinline__ bool keep(const Unit&) const { return false; }
    __device__ __forceinline__ void operator()(Acc& acc, const Unit& u, int wr, int wc, int fr, int fq) const {
        const int row0 = u.pm * BM + wr * 64 + fr, col0 = u.pn * BM + wc * 32 + 8 * fq;
#pragma unroll
        for (int ai = 0; ai < 2; ++ai)
#pragma unroll
            for (int m = 0; m < 4; ++m) { bf16_t* rowp = O + (size_t)(row0 + ai * HALF + m * 16) * ldc + col0;
#pragma unroll
                for (int bj = 0; bj < 2; ++bj) *(u32x4*)(rowp + bj * HALF) = pack8(acc[ai][bj][m][0], acc[ai][bj][m][1]); }
    }
};

struct EpiIn {
    static constexpr bool PERM = true;
    bf16_t *U, *V, *BG, *P, *SGA, *SGB; float* VSS;
    __device__ __forceinline__ bool keep(const Unit&) const { return false; }
    __device__ __forceinline__ void operator()(Acc& acc, const Unit& u, int wr, int wc, int fr, int fq) const {
        const int row0 = u.pm * BM + wr * 64 + fr; const int pn = u.pn;
        if (pn >= 24 && pn < 40) {
            const int col0 = (pn - 24) * HALF + wc * 32 + 8 * fq;
#pragma unroll
            for (int ai = 0; ai < 2; ++ai)
#pragma unroll
                for (int m = 0; m < 4; ++m) {
                    const f32x4 p0 = acc[ai][0][m][0] * acc[ai][1][m][0], p1 = acc[ai][0][m][1] * acc[ai][1][m][1];
                    *(u32x4*)(P + (size_t)(row0 + ai * HALF + m * 16) * DM + col0) = pack8(p0, p1); }
            return;
        }
        bf16_t* O; int ct; bool sig = false, ss = false;
        if (pn < 8) { O = U; ct = pn; } else if (pn < 16) { O = V; ct = pn - 8; ss = true; } else if (pn < 24) { O = BG; ct = pn - 16; }
        else if (pn < 48) { O = SGA; ct = pn - 40; sig = true; } else { O = SGB; ct = pn - 48; sig = true; }
        const int col0 = ct * BM + wc * 32 + 8 * fq;
#pragma unroll
        for (int ai = 0; ai < 2; ++ai)
#pragma unroll
            for (int m = 0; m < 4; ++m) {
                const int row = row0 + ai * HALF + m * 16; bf16_t* rowp = O + (size_t)row * DM + col0;
                if (ss) { float s = 0.f;
#pragma unroll
                    for (int bj = 0; bj < 2; ++bj)
#pragma unroll
                        for (int n = 0; n < 2; ++n) { const f32x4 x = acc[ai][bj][m][n]; s += (x[0] * x[0] + x[1] * x[1]) + (x[2] * x[2] + x[3] * x[3]); }
                    s += __shfl_xor(s, 16); s += __shfl_xor(s, 32);
                    if (fq == 0) VSS[(size_t)row * 32 + ct * 4 + wc] = s; }
#pragma unroll
                for (int bj = 0; bj < 2; ++bj) { f32x4 v0 = acc[ai][bj][m][0], v1 = acc[ai][bj][m][1];
                    if (sig) {
#pragma unroll
                        for (int i = 0; i < 4; ++i) { v0[i] = sigmoidf_(v0[i]); v1[i] = sigmoidf_(v1[i]); } }
                    *(u32x4*)(rowp + bj * HALF) = pack8(v0, v1); } }
    }
};

struct EpiOut {
    static constexpr bool PERM = true;
    const bf16_t *SGA, *SGB; bf16_t* O;
    __device__ __forceinline__ bool keep(const Unit& u) const { return u.part == 0; }
    __device__ __forceinline__ void operator()(Acc& acc, const Unit& u, int wr, int wc, int fr, int fq) const {
        const int row0 = u.pm * BM + wr * 64 + fr, col0 = u.pn * BM + wc * 32 + 8 * fq;
#pragma unroll
        for (int ai = 0; ai < 2; ++ai)
#pragma unroll
            for (int m = 0; m < 4; ++m) { const size_t off = (size_t)(row0 + ai * HALF + m * 16) * DM + col0;
#pragma unroll
                for (int bj = 0; bj < 2; ++bj) {
                    const u32x4 a = *(const u32x4*)(SGA + off + bj * HALF);
                    f32x4 a0 = {bf_lo(a.x), bf_hi(a.x), bf_lo(a.y), bf_hi(a.y)}, a1 = {bf_lo(a.z), bf_hi(a.z), bf_lo(a.w), bf_hi(a.w)};
                    if (u.part == 0) {
                        const u32x4 b = *(const u32x4*)(SGB + off + bj * HALF);
                        const f32x4 b0 = {bf_lo(b.x), bf_hi(b.x), bf_lo(b.y), bf_hi(b.y)}, b1 = {bf_lo(b.z), bf_hi(b.z), bf_lo(b.w), bf_hi(b.w)};
#pragma unroll
                        for (int i = 0; i < 4; ++i) { acc[ai][bj][m][0][i] *= b0[i] * __builtin_amdgcn_rcpf(a0[i]); acc[ai][bj][m][1][i] *= b1[i] * __builtin_amdgcn_rcpf(a1[i]); }
                    } else {
                        *(u32x4*)(O + off + bj * HALF) = pack8(acc[ai][bj][m][0] * a0, acc[ai][bj][m][1] * a1);
                    } }
                asm volatile("" ::: "memory"); }
    }
};

struct EpiUp {
    static constexpr bool PERM = true;
    bf16_t *A, *B;
    __device__ __forceinline__ bool keep(const Unit&) const { return false; }
    __device__ __forceinline__ void operator()(Acc& acc, const Unit& u, int wr, int wc, int fr, int fq) const {
        const int row0 = u.pm * BM + wr * 64 + fr, col0 = u.pn * HALF + wc * 32 + 8 * fq;
#pragma unroll
        for (int ai = 0; ai < 2; ++ai)
#pragma unroll
            for (int m = 0; m < 4; ++m) { const size_t off = (size_t)(row0 + ai * HALF + m * 16) * DFF + col0;
                *(u32x4*)(A + off) = pack8(acc[ai][0][m][0], acc[ai][0][m][1]);
                *(u32x4*)(B + off) = pack8(acc[ai][1][m][0], acc[ai][1][m][1]); }
    }
};

template <class Epi, class Sched, bool ALIGN_EPI, bool SP2>
__device__ __forceinline__ void gemm_phase(LAS unsigned char* lds, const Ptrs g, const int K, const Sched& S, const Epi& E) {
    const int tid = threadIdx.x, wid = __builtin_amdgcn_readfirstlane(tid >> 6), lane = tid & 63, wr = wid >> 2, wc = wid & 3, fr = lane & 15, fq = lane >> 4;
    const int nt = K / BK;
    unsigned voffA[2], voffB[2];
#pragma unroll
    for (int i = 0; i < 2; ++i) { int R, C; stage_rc(tid * 16 + i * 8192, R, C); const int Rb = Epi::PERM ? ((R & ~31) + perm32(R & 31)) : R;
        voffA[i] = (unsigned)(R * g.lda + C) * 2u; voffB[i] = (unsigned)(Rb * g.ldb + C) * 2u; }
    const size_t kstep = (size_t)(BK * 2);
    const size_t hstepA = (size_t)HALF * g.lda * 2, hstepB = (size_t)HALF * g.ldb * 2;
    const unsigned ldsw = (unsigned)wid * 1024u;
    const int aoff = lds_byte(wr * 64 + fr, fq * 8), boff = lds_byte(wc * 32 + fr, fq * 8);
#define PG8_SA(b, h) (((b) * 2 + (h)) * HTB)
#define PG8_SB(b, h) ((4 + (b) * 2 + (h)) * HTB)
#define PG8_STAGE(bufoff, gbase, voff) do { _Pragma("unroll") for (int _i = 0; _i < 2; ++_i) \
        __builtin_amdgcn_global_load_lds((const unsigned*)((const char*)(gbase) + (voff)[_i]), (LAS unsigned*)(lds + (bufoff) + ldsw + _i * 8192), 16, 0, 0); } while (0)
#define PG8_LDA(dst, b, h) do { _Pragma("unroll") for (int m = 0; m < 4; ++m) _Pragma("unroll") for (int k = 0; k < 2; ++k) dst[m][k] = *(const LAS bf16x8*)(lds + PG8_SA(b, h) + aoff + m * 2048 + k * 1024); } while (0)
#define PG8_LDB(dst, b, h) do { _Pragma("unroll") for (int n = 0; n < 2; ++n) _Pragma("unroll") for (int k = 0; k < 2; ++k) dst[n][k] = *(const LAS bf16x8*)(lds + PG8_SB(b, h) + boff + n * 2048 + k * 1024); } while (0)
#define PG8_MMA(ai, bj, At, Bt) do { __builtin_amdgcn_s_setprio(1); _Pragma("unroll") for (int m = 0; m < 4; ++m) _Pragma("unroll") for (int n = 0; n < 2; ++n) _Pragma("unroll") for (int k = 0; k < 2; ++k) \
        acc[ai][bj][m][n] = __builtin_amdgcn_mfma_f32_16x16x32_bf16(Bt[n][k], At[m][k], acc[ai][bj][m][n], 0, 0, 0); __builtin_amdgcn_s_setprio(0); } while (0)
#define PG8_WAIT_V(n) asm volatile("s_waitcnt vmcnt(" #n ")" ::: "memory")
#define PG8_WAIT_L(n) asm volatile("s_waitcnt lgkmcnt(" #n ")" ::: "memory")
#define PG8_BAR __builtin_amdgcn_s_barrier()
#define PG8_SCHED __builtin_amdgcn_sched_barrier(0)
    Unit cur, nxt; int ui = 0;
    if (!S.next(0, cur)) return;
    Acc acc;
#pragma unroll
    for (int a = 0; a < 2; ++a)
#pragma unroll
        for (int b = 0; b < 2; ++b)
#pragma unroll
            for (int m = 0; m < 4; ++m)
#pragma unroll
                for (int n = 0; n < 2; ++n) acc[a][b][m][n] = (f32x4){0.f, 0.f, 0.f, 0.f};
    bf16x8 At[4][2], B0[2][2], B1[2][2];
    const char* cA = g.a(cur); const char* cB = g.b(cur);
    if constexpr (SP2) {
        PG8_STAGE(PG8_SB(0, 0), cB, voffB); PG8_STAGE(PG8_SB(0, 1), cB + hstepB, voffB); PG8_STAGE(PG8_SA(0, 0), cA, voffA); PG8_STAGE(PG8_SA(0, 1), cA + hstepA, voffA);
        if (wr == 1) PG8_BAR;
        PG8_WAIT_V(2); PG8_BAR;
        PG8_STAGE(PG8_SB(1, 0), cB + kstep, voffB); PG8_STAGE(PG8_SA(1, 0), cA + kstep, voffA); PG8_STAGE(PG8_SB(1, 1), cB + hstepB + kstep, voffB);
        PG8_WAIT_V(6); PG8_BAR;
    } else {
        PG8_STAGE(PG8_SB(0, 0), cB, voffB); PG8_STAGE(PG8_SA(0, 0), cA, voffA); PG8_STAGE(PG8_SB(0, 1), cB + hstepB, voffB); PG8_STAGE(PG8_SA(0, 1), cA + hstepA, voffA);
        if (wr == 1) PG8_BAR;
        PG8_WAIT_V(4); PG8_BAR;
        PG8_STAGE(PG8_SB(1, 0), cB + kstep, voffB); PG8_STAGE(PG8_SA(1, 0), cA + kstep, voffA); PG8_STAGE(PG8_SB(1, 1), cB + hstepB + kstep, voffB);
        PG8_WAIT_V(6); PG8_BAR;
    }
    for (;;) {
        const bool has_next = S.next(ui + 1, nxt);
        const char* nA = has_next ? g.a(nxt) : cA; const char* nB = has_next ? g.b(nxt) : cB;
        for (int t = 0; t < nt; t += 2) {
            const bool last = (t == nt - 2);
            const char* a1 = cA + (size_t)(t + 1) * kstep;
            const char* a2 = last ? nA : cA + (size_t)(t + 2) * kstep; const char* b2 = last ? nB : cB + (size_t)(t + 2) * kstep;
            const char* a3 = a2 + kstep; const char* b3 = b2 + kstep;
            if constexpr (SP2) {
            PG8_LDB(B0, 0, 0); PG8_LDB(B1, 0, 1); PG8_SCHED; PG8_LDA(At, 0, 0); PG8_STAGE(PG8_SA(1, 1), a1 + hstepA, voffA);
            PG8_WAIT_V(8); PG8_WAIT_L(0); PG8_BAR; PG8_MMA(0, 0, At, B0); PG8_MMA(0, 1, At, B1); PG8_BAR; PG8_SCHED;
            PG8_LDA(At, 0, 1); PG8_STAGE(PG8_SB(0, 0), b2, voffB); PG8_STAGE(PG8_SB(0, 1), b2 + hstepB, voffB); PG8_STAGE(PG8_SA(0, 0), a2, voffA);
            PG8_WAIT_V(8); PG8_WAIT_L(0); PG8_BAR; PG8_MMA(1, 0, At, B0); PG8_MMA(1, 1, At, B1); PG8_BAR; PG8_SCHED;
            PG8_LDB(B0, 1, 0); PG8_LDB(B1, 1, 1); PG8_SCHED; PG8_LDA(At, 1, 0); PG8_STAGE(PG8_SA(0, 1), a2 + hstepA, voffA);
            PG8_WAIT_V(8); PG8_WAIT_L(0); PG8_BAR; PG8_MMA(0, 0, At, B0); PG8_MMA(0, 1, At, B1); PG8_BAR; PG8_SCHED;
            PG8_LDA(At, 1, 1); PG8_STAGE(PG8_SB(1, 0), b3, voffB); PG8_STAGE(PG8_SB(1, 1), b3 + hstepB, voffB); PG8_STAGE(PG8_SA(1, 0), a3, voffA);
            PG8_WAIT_V(8); PG8_WAIT_L(0); PG8_BAR; PG8_MMA(1, 0, At, B0); PG8_MMA(1, 1, At, B1); PG8_BAR; PG8_SCHED;
            } else {
            PG8_LDB(B0, 0, 0); PG8_SCHED; PG8_LDA(At, 0, 0); PG8_STAGE(PG8_SA(1, 1), a1 + hstepA, voffA);
            PG8_WAIT_L(8); PG8_BAR; PG8_WAIT_L(0); PG8_MMA(0, 0, At, B0); PG8_BAR; PG8_SCHED;
            PG8_LDB(B1, 0, 1); PG8_STAGE(PG8_SB(0, 0), b2, voffB);
            PG8_BAR; PG8_WAIT_L(0); PG8_MMA(0, 1, At, B1); PG8_BAR;
            PG8_LDA(At, 0, 1); PG8_STAGE(PG8_SA(0, 0), a2, voffA);
            PG8_BAR; PG8_WAIT_L(0); PG8_MMA(1, 0, At, B0); PG8_BAR; PG8_SCHED;
            PG8_STAGE(PG8_SB(0, 1), b2 + hstepB, voffB);
            PG8_WAIT_V(6); PG8_BAR; PG8_MMA(1, 1, At, B1); PG8_BAR;
            PG8_LDB(B0, 1, 0); PG8_SCHED; PG8_LDA(At, 1, 0); PG8_STAGE(PG8_SA(0, 1), a2 + hstepA, voffA);
            PG8_WAIT_L(8); PG8_BAR; PG8_WAIT_L(0); PG8_MMA(0, 0, At, B0); PG8_BAR; PG8_SCHED;
            PG8_LDB(B1, 1, 1); PG8_STAGE(PG8_SB(1, 0), b3, voffB);
            PG8_BAR; PG8_WAIT_L(0); PG8_MMA(0, 1, At, B1); PG8_BAR;
            PG8_LDA(At, 1, 1); PG8_STAGE(PG8_SA(1, 0), a3, voffA);
            PG8_BAR; PG8_WAIT_L(0); PG8_MMA(1, 0, At, B0); PG8_BAR; PG8_SCHED;
            PG8_STAGE(PG8_SB(1, 1), b3 + hstepB, voffB);
            PG8_WAIT_V(6); PG8_BAR; PG8_MMA(1, 1, At, B1); PG8_BAR;
            }
        }
        if constexpr (ALIGN_EPI) { if (wr == 0) PG8_BAR; }
        E(acc, cur, wr, wc, fr, fq);
        if (!E.keep(cur)) {
#pragma unroll
            for (int a = 0; a < 2; ++a)
#pragma unroll
                for (int b = 0; b < 2; ++b)
#pragma unroll
                    for (int m = 0; m < 4; ++m)
#pragma unroll
                        for (int n = 0; n < 2; ++n) acc[a][b][m][n] = (f32x4){0.f, 0.f, 0.f, 0.f};
        }
        if (!has_next) break;
        cur = nxt; cA = nA; cB = nB; ++ui;
        if constexpr (ALIGN_EPI) { if (wr == 1) PG8_BAR; }
    }
    PG8_WAIT_V(0);
    if constexpr (!ALIGN_EPI) { if (wr == 0) PG8_BAR; }
    PG8_BAR;
#undef PG8_SA
#undef PG8_SB
#undef PG8_STAGE
#undef PG8_LDA
#undef PG8_LDB
#undef PG8_MMA
#undef PG8_WAIT_V
#undef PG8_WAIT_L
#undef PG8_BAR
#undef PG8_SCHED
}
}


namespace sg {
struct EpiSum {
    bf16_t* O; int ldc;
    __device__ __forceinline__ void operator()(int row, int col, const f32x4& s0, const f32x4& s1) const {
        const f32x4 r = s0 + s1; u32x2 o; o.x = pg8::cvt_pk_bf16(r[0], r[1]); o.y = pg8::cvt_pk_bf16(r[2], r[3]);
        *(u32x2*)(O + (size_t)row * ldc + col) = o; }
};
struct EpiOutS {
    const bf16_t *SGA, *SGB; bf16_t* O;
    __device__ __forceinline__ void operator()(int row, int col, const f32x4& s0, const f32x4& s1) const {
        const size_t off = (size_t)row * DM + col; const u32x2 a = *(const u32x2*)(SGA + off), b = *(const u32x2*)(SGB + off);
        const f32x4 av = {pg8::bf_lo(a.x), pg8::bf_hi(a.x), pg8::bf_lo(a.y), pg8::bf_hi(a.y)}, bv = {pg8::bf_lo(b.x), pg8::bf_hi(b.x), pg8::bf_lo(b.y), pg8::bf_hi(b.y)};
        const f32x4 r = av * s1 + bv * s0; u32x2 o; o.x = pg8::cvt_pk_bf16(r[0], r[1]); o.y = pg8::cvt_pk_bf16(r[2], r[3]);
        *(u32x2*)(O + off) = o; }
};
struct EpiF32B {
    float* C; int ldc; const float* bias;
    __device__ __forceinline__ void operator()(int row, int col, const f32x4& s0, const f32x4& s1) const {
        *(f32x4*)(C + (size_t)row * ldc + col) = s0 + s1 + *(const f32x4*)(bias + col); }
};
template <class Epi>
__device__ __forceinline__ void small_gemm(LAS unsigned char* lds, const bf16_t* A0, const bf16_t* B0, const bf16_t* A1, const bf16_t* B1,
                                           const int lda, const int ldb, const int K, const int parts, const int row0, const int col0, const Epi& E) {
    const int tid = threadIdx.x, w = __builtin_amdgcn_readfirstlane(tid >> 6), lane = tid & 63, fr = lane & 15, fq = lane >> 4;
    const int part = parts == 2 ? (w >> 2) : 0, kw = parts == 2 ? (w & 3) : w, klen = parts == 2 ? K / 4 : K / 8;
    const bf16_t* Ap = (part ? A1 : A0) + (size_t)(row0 + fr) * lda + kw * klen + 8 * fq;
    const bf16_t* Bp = (part ? B1 : B0) + (size_t)(col0 + fr) * ldb + kw * klen + 8 * fq;
    const int nsteps = klen / 32;
    f32x4 acc[4][4];
#pragma unroll
    for (int m = 0; m < 4; ++m)
#pragma unroll
        for (int n = 0; n < 4; ++n) acc[m][n] = (f32x4){0.f, 0.f, 0.f, 0.f};
    bf16x8 a0[4], b0[4], a1[4], b1[4];
#define SG_LD(av, bv, s) do { _Pragma("unroll") for (int m = 0; m < 4; ++m) { av[m] = *(const bf16x8*)(Ap + (size_t)(16 * m) * lda + 32 * (s)); bv[m] = *(const bf16x8*)(Bp + (size_t)(16 * m) * ldb + 32 * (s)); } } while (0)
#define SG_MM(av, bv) do { _Pragma("unroll") for (int m = 0; m < 4; ++m) _Pragma("unroll") for (int n = 0; n < 4; ++n) acc[m][n] = __builtin_amdgcn_mfma_f32_16x16x32_bf16(bv[n], av[m], acc[m][n], 0, 0, 0); } while (0)
    SG_LD(a0, b0, 0);
    for (int s = 0; s < nsteps; s += 2) {
        SG_LD(a1, b1, s + 1);
        SG_MM(a0, b0);
        if (s + 2 < nsteps) SG_LD(a0, b0, s + 2);
        SG_MM(a1, b1);
    }
#undef SG_LD
#undef SG_MM
#pragma unroll
    for (int m = 0; m < 4; ++m)
#pragma unroll
        for (int n = 0; n < 4; ++n) *(LAS f32x4*)(lds + (size_t)(((w * 16 + m * 4 + n) * 64 + lane) * 16)) = acc[m][n];
    __syncthreads();
#pragma unroll
    for (int q = 0; q < 2; ++q) {
        const int p = w + 8 * q; f32x4 s0 = {0.f, 0.f, 0.f, 0.f}, s1 = {0.f, 0.f, 0.f, 0.f};
#pragma unroll
        for (int ww = 0; ww < 4; ++ww) { s0 += *(const LAS f32x4*)(lds + (size_t)(((ww * 16 + p) * 64 + lane) * 16)); s1 += *(const LAS f32x4*)(lds + (size_t)((((ww + 4) * 16 + p) * 64 + lane) * 16)); }
        const int m = p >> 2, n = p & 3;
        E(row0 + 16 * m + fr, col0 + 16 * n + 4 * fq, s0, s1);
    }
    __syncthreads();
}
}

constexpr int NWAVES = 8;
#ifndef MK_N_LAUNCHES
#define MK_N_LAUNCHES 1
#endif
constexpr int NPHASES = 12;
constexpr int N_LAUNCHES = MK_N_LAUNCHES;
constexpr bool K_SP2 = true, K_ALIGN = true;

constexpr int CW_BAR = 4096;
constexpr int RING_OFF = 0, RING_BYTES = 131072;
constexpr int LDSCTL_OFF = RING_BYTES, MISC_OFF = LDSCTL_OFF + 320;
constexpr int LDS_BYTES = 147456;

typedef GAS unsigned gu32;
#define RLX_AGENT __ATOMIC_RELAXED, __HIP_MEMORY_SCOPE_AGENT
#define LDS_WAIT() asm volatile("s_waitcnt lgkmcnt(0)" ::: "memory")
#define VM_WAIT() asm volatile("s_waitcnt vmcnt(0)" ::: "memory")
__device__ __forceinline__ unsigned f2bf(float f) { unsigned u = __builtin_bit_cast(unsigned, f); return (u + 0x7fffu + ((u >> 16) & 1u)) >> 16; }
__device__ __forceinline__ unsigned pk2(float lo, float hi) { return f2bf(lo) | (f2bf(hi) << 16); }
using pg8::bf_lo; using pg8::bf_hi;

#define XB_TMO      128
#define XB_XCNT(j)  (256  + 64 * (j))
#define XB_XSUB(j)  (1280 + 64 * (j))
#define XB_XGEN(j)  (2304 + 64 * (j))
#define XB_TOP      3328
#define XB_TOPGEN   3392
#define XCD_BAR_WORDS 3456
#define XB_SPIN_CAP (1u << 22)
__device__ __forceinline__ unsigned xb_ld(unsigned* p)              { return __hip_atomic_load(p, __ATOMIC_RELAXED, __HIP_MEMORY_SCOPE_AGENT); }
__device__ __forceinline__ unsigned xb_add(unsigned* p, unsigned v) { return __hip_atomic_fetch_add(p, v, __ATOMIC_RELAXED, __HIP_MEMORY_SCOPE_AGENT); }
__device__ __forceinline__ unsigned xb_xcc_id() { return (unsigned)__builtin_amdgcn_s_getreg((3 << 11) | 20) & 0xFu; }
#define XB_SPIN(cond, bar) do { unsigned _sp = 0; while (cond) { __builtin_amdgcn_s_sleep(1); \
    if ((++_sp & 255u) == 0u) { if (xb_ld(&(bar)[XB_TMO])) break; if (_sp > XB_SPIN_CAP) { atomicAdd(&(bar)[XB_TMO], 1u); break; } } } } while (0)
struct XcdBarrier { unsigned* bar; unsigned x; volatile LAS unsigned* st; };
__device__ __forceinline__ XcdBarrier xcd_barrier_post(unsigned* bar, volatile LAS unsigned* st) {
    XcdBarrier b; b.bar = bar; b.x = xb_xcc_id(); b.st = st;
    if (threadIdx.x == 0) (void)xb_add(&bar[XB_XCNT(b.x)], 1u);
    return b;
}
__device__ __forceinline__ void xcd_barrier_complete(unsigned* bar, unsigned x, unsigned& nloc, unsigned& nx) {
    const unsigned G = gridDim.x * gridDim.y * gridDim.z;
    unsigned sum, cnt, mine, sp = 0u;
    for (;;) {
        sum = 0u; cnt = 0u; mine = 0u;
#pragma unroll
        for (unsigned j = 0; j < 16; ++j) { const unsigned c = xb_ld(&bar[XB_XCNT(j)]); sum += c; cnt += (c > 0u) ? 1u : 0u; mine = (j == x) ? c : mine; }
        if (sum == G) break;
        __builtin_amdgcn_s_sleep(1);
        if ((++sp & 255u) == 0u) { if (xb_ld(&bar[XB_TMO])) break; if (sp > XB_SPIN_CAP) { atomicAdd(&bar[XB_TMO], 1u); break; } }
    }
    nloc = mine > 0u ? mine : 1u; nx = cnt > 0u ? cnt : 1u;
}
__device__ __forceinline__ void xcd_barrier(const XcdBarrier& b) {
    asm volatile("s_waitcnt vmcnt(0)" ::: "memory");
    __syncthreads();
    if (threadIdx.x == 0) {
        unsigned* bar = b.bar;
        __builtin_amdgcn_s_waitcnt(0);
        unsigned nloc = b.st[0], nx = b.st[1];
        if (nloc == 0u) { xcd_barrier_complete(bar, b.x, nloc, nx); b.st[0] = nloc; b.st[1] = nx; }
        const unsigned old = xb_add(&bar[XB_XSUB(b.x)], 1u);
        const unsigned gen = old / nloc;
        if (old + 1u == (gen + 1u) * nloc) {
            __builtin_amdgcn_fence(__ATOMIC_RELEASE, "agent");
            asm volatile("s_waitcnt vmcnt(0)" ::: "memory");
            const unsigned og = xb_add(&bar[XB_TOP], 1u);
            const unsigned tg = og / nx;
            if (og + 1u == (tg + 1u) * nx) xb_add(&bar[XB_TOPGEN], 1u);
            else XB_SPIN(xb_ld(&bar[XB_TOPGEN]) == tg, bar);
            __builtin_amdgcn_fence(__ATOMIC_ACQUIRE, "agent");
            xb_add(&bar[XB_XGEN(b.x)], 1u);
            asm volatile("s_waitcnt vmcnt(0)" ::: "memory");
        } else {
            XB_SPIN(xb_ld(&bar[XB_XGEN(b.x)]) == gen, bar);
            __builtin_amdgcn_fence(__ATOMIC_ACQUIRE, "agent");
            asm volatile("s_waitcnt vmcnt(0)" ::: "memory");
        }
    }
    __syncthreads();
}

struct Args { const float* in[23]; float* out; unsigned char* ws; int ph_lo, ph_hi, li, pad; };
struct Frame {
    LAS unsigned char* lds;
    int tid, lane, wave, vcu, G;
    const float* const* in;
    float* out; unsigned char* ws;
};
__device__ __forceinline__ float wave_sum(float v) {
#pragma unroll
    for (int o = 1; o < 64; o <<= 1) v += __shfl_xor(v, o);
    return v;
}
__device__ __forceinline__ float sigm(float x) { return 1.0f / (1.0f + __expf(-x)); }
__device__ __forceinline__ float gelu_tanh(float x) { const float z = 1.5957691216f * (x + 0.044715f * x * x * x); return x / (1.0f + __expf(-z)); }

__device__ __forceinline__ void p0_transpose_item(const float* W, int K, int N, bf16_t* WT, int k0, int n0, int drow0, LAS float* scr, int lane) {
#pragma unroll 8
    for (int i = 0; i < 32; ++i) { const int kk = 2 * i + (lane >> 5); scr[kk * 33 + (lane & 31)] = W[(size_t)(k0 + kk) * N + n0 + (lane & 31)]; }
    LDS_WAIT(); asm volatile("" ::: "memory");
    const int c = lane & 7;
#pragma unroll
    for (int j = 0; j < 4; ++j) { const int n = (lane >> 3) + 8 * j; const LAS float* s = scr + (8 * c) * 33 + n;
        u32x4 o; o.x = pk2(s[0 * 33], s[1 * 33]); o.y = pk2(s[2 * 33], s[3 * 33]); o.z = pk2(s[4 * 33], s[5 * 33]); o.w = pk2(s[6 * 33], s[7 * 33]);
        *(GAS u32x4*)(WT + (size_t)(drow0 + n) * K + k0 + 8 * c) = o; }
    LDS_WAIT(); asm volatile("" ::: "memory");
}
__device__ __forceinline__ int win_drow(int n0) {
    const int seg = n0 >> 11, off = n0 & 2047;
    if (seg == 3) return 6144 + (off >> 7) * 256 + (off & 127);
    if (seg == 4) return 6144 + (off >> 7) * 256 + 128 + (off & 127);
    return n0;
}
__device__ __forceinline__ int wup_drow(int n0) {
    const int seg = n0 >= DFF ? 1 : 0, off = n0 - seg * DFF;
    return (off >> 7) * 256 + seg * 128 + (off & 127);
}
__device__ __forceinline__ void p0_prologue(Frame& F) {
    LAS float* scr = (LAS float*)(F.lds + RING_OFF + F.wave * 16384);
    const int gw = F.vcu * NWAVES + F.wave, NGW = F.G * NWAVES;
    const float* w_ada = F.in[6]; const float* w_in = F.in[10]; const float* w_out_a = F.in[15]; const float* w_out_b = F.in[16]; const float* w_o = F.in[17];
    const float* w_up = F.in[20]; const float* w_down = F.in[22];
    bf16_t* WinT = (bf16_t*)(F.ws + WS_WIN); bf16_t* WadaT = (bf16_t*)(F.ws + WS_WADA); bf16_t* WbT = (bf16_t*)(F.ws + WS_WB); bf16_t* WaT = (bf16_t*)(F.ws + WS_WA);
    bf16_t* WoT = (bf16_t*)(F.ws + WS_WO); bf16_t* WupT = (bf16_t*)(F.ws + WS_WUP); bf16_t* WdT = (bf16_t*)(F.ws + WS_WD);
    constexpr int I_ADA = (DM / 64) * (NMODC / 32), I_IN = (DM / 64) * (INW / 32), I_SQ = (DM / 64) * (DM / 32), I_UP = (DM / 64) * (2 * DFF / 32), I_DN = (DFF / 64) * (DM / 32);
    constexpr int NITEMS = I_ADA + I_IN + 3 * I_SQ + I_UP + I_DN;
    for (int it = gw; it < NITEMS; it += NGW) {
        int r = it;
        if (r < I_ADA) { const int nblk = NMODC / 32, kb = r / nblk, nb = r % nblk; p0_transpose_item(w_ada, DM, NMODC, WadaT, kb * 64, nb * 32, nb * 32, scr, F.lane); continue; } r -= I_ADA;
        if (r < I_IN) { const int nblk = INW / 32, kb = r / nblk, nb = r % nblk; p0_transpose_item(w_in, DM, INW, WinT, kb * 64, nb * 32, win_drow(nb * 32), scr, F.lane); continue; } r -= I_IN;
        if (r < I_SQ) { const int nblk = DM / 32, kb = r / nblk, nb = r % nblk; p0_transpose_item(w_out_b, DM, DM, WbT, kb * 64, nb * 32, nb * 32, scr, F.lane); continue; } r -= I_SQ;
        if (r < I_SQ) { const int nblk = DM / 32, kb = r / nblk, nb = r % nblk; p0_transpose_item(w_out_a, DM, DM, WaT, kb * 64, nb * 32, nb * 32, scr, F.lane); continue; } r -= I_SQ;
        if (r < I_SQ) { const int nblk = DM / 32, kb = r / nblk, nb = r % nblk; p0_transpose_item(w_o, DM, DM, WoT, kb * 64, nb * 32, nb * 32, scr, F.lane); continue; } r -= I_SQ;
        if (r < I_UP) { const int nblk = 2 * DFF / 32, kb = r / nblk, nb = r % nblk; p0_transpose_item(w_up, DM, 2 * DFF, WupT, kb * 64, nb * 32, wup_drow(nb * 32), scr, F.lane); continue; } r -= I_UP;
        { const int nblk = DM / 32, kb = r / nblk, nb = r % nblk; p0_transpose_item(w_down, DFF, DM, WdT, kb * 64, nb * 32, nb * 32, scr, F.lane); }
    }
    bf16_t* S = (bf16_t*)(F.ws + WS_S);
    const float* c_p = F.in[2]; const float* c_s = F.in[3];
    for (int r = gw; r < 256; r += NGW) {
        const float* src = r < NB ? c_p + (size_t)r * DM : c_s + (size_t)(r - NB) * DM;
#pragma unroll
        for (int j = 0; j < 8; ++j) { const int c = 4 * F.lane + 256 * j; u32x2 o = {0u, 0u};
            if (r < NBIDX) { const f32x4 v = *(const f32x4*)(src + c); o.x = pk2(v[0] * sigm(v[0]), v[1] * sigm(v[1])); o.y = pk2(v[2] * sigm(v[2]), v[3] * sigm(v[3])); }
            *(u32x2*)(S + (size_t)r * DM + c) = o; }
    }
}

__device__ __forceinline__ void p_h1(Frame& F) {
    const int gw = F.vcu * NWAVES + F.wave, NGW = F.G * NWAVES;
    const float* g_pre = F.in[8]; const float* MOD = (const float*)(F.ws + WS_MOD); bf16_t* H1 = (bf16_t*)(F.ws + WS_H1);
    for (int r = gw; r < M; r += NGW) {
        const float* xrow = r < MP ? F.in[0] + (size_t)r * DM : F.in[1] + (size_t)(r - MP) * DM;
        const int bidx = r < MP ? r / SEQ : NB + (r - MP) / DS;
        const float* mod = MOD + (size_t)bidx * NMODC;
        f32x4 v[8]; float s = 0.f;
#pragma unroll
        for (int j = 0; j < 8; ++j) { v[j] = *(const f32x4*)(xrow + 4 * F.lane + 256 * j); s += (v[j][0] * v[j][0] + v[j][1] * v[j][1]) + (v[j][2] * v[j][2] + v[j][3] * v[j][3]); }
        const float rstd = 1.0f / sqrtf(wave_sum(s) * (1.0f / DM) + EPS);
#pragma unroll
        for (int j = 0; j < 8; ++j) { const int c = 4 * F.lane + 256 * j;
            const f32x4 g = *(const f32x4*)(g_pre + c), sh = *(const f32x4*)(mod + c), sc = *(const f32x4*)(mod + DM + c);
            const f32x4 h = v[j] * rstd * g * (sc + 1.0f) + sh;
            u32x2 o; o.x = pk2(h[0], h[1]); o.y = pk2(h[2], h[3]);
            *(u32x2*)(H1 + (size_t)r * DM + c) = o; }
    }
}

template <int ACT>
__device__ __forceinline__ void conv_gate(Frame& F, const bf16_t* A, const bf16_t* B, bf16_t* O, const int C, const float* w, const float* state, float* out_p, float* out_s) {
    const int C8 = C / 8, NRB = M / 16, total = NRB * C8;
    const int gtid = F.vcu * (NWAVES * 64) + F.tid, NT = F.G * NWAVES * 64;
    for (int idx = gtid; idx < total; idx += NT) {
        const int c8 = idx % C8, rb = idx / C8, c = c8 * 8, r0 = rb * 16;
        float w0[8], w1[8], w2[8];
#pragma unroll
        for (int h = 0; h < 2; ++h) { const f32x4 a = *(const f32x4*)(w + c + 4 * h), b = *(const f32x4*)(w + C + c + 4 * h), d = *(const f32x4*)(w + 2 * C + c + 4 * h);
#pragma unroll
            for (int i = 0; i < 4; ++i) { w0[4 * h + i] = a[i]; w1[4 * h + i] = b[i]; w2[4 * h + i] = d[i]; } }
        float p2[8], p1[8];
        const bool prompt = r0 < MP;
        const int t0 = prompt ? (r0 % SEQ) : 0, bb = prompt ? (r0 / SEQ) : 0;
        if (prompt) {
            if (t0 == 0) {
#pragma unroll
                for (int i = 0; i < 8; ++i) { p2[i] = 0.f; p1[i] = 0.f; }
            } else {
                const u32x4 q2 = *(const u32x4*)(A + (size_t)(r0 - 2) * C + c), q1 = *(const u32x4*)(A + (size_t)(r0 - 1) * C + c);
                p2[0] = bf_lo(q2.x); p2[1] = bf_hi(q2.x); p2[2] = bf_lo(q2.y); p2[3] = bf_hi(q2.y); p2[4] = bf_lo(q2.z); p2[5] = bf_hi(q2.z); p2[6] = bf_lo(q2.w); p2[7] = bf_hi(q2.w);
                p1[0] = bf_lo(q1.x); p1[1] = bf_hi(q1.x); p1[2] = bf_lo(q1.y); p1[3] = bf_hi(q1.y); p1[4] = bf_lo(q1.z); p1[5] = bf_hi(q1.z); p1[6] = bf_lo(q1.w); p1[7] = bf_hi(q1.w);
            }
        }
#pragma unroll 4
        for (int i = 0; i < 16; ++i) {
            const int r = r0 + i;
            if (!prompt && (i & 3) == 0) {
                const int sb = (r - MP) >> 2;
#pragma unroll
                for (int h = 0; h < 2; ++h) { const f32x4 s2 = *(const f32x4*)(state + ((size_t)sb * 2 + 0) * C + c + 4 * h), s1 = *(const f32x4*)(state + ((size_t)sb * 2 + 1) * C + c + 4 * h);
#pragma unroll
                    for (int k = 0; k < 4; ++k) { p2[4 * h + k] = s2[k]; p1[4 * h + k] = s1[k]; } }
            }
            const u32x4 qa = *(const u32x4*)(A + (size_t)r * C + c), qb = *(const u32x4*)(B + (size_t)r * C + c);
            float a[8], b[8], o[8];
            a[0] = bf_lo(qa.x); a[1] = bf_hi(qa.x); a[2] = bf_lo(qa.y); a[3] = bf_hi(qa.y); a[4] = bf_lo(qa.z); a[5] = bf_hi(qa.z); a[6] = bf_lo(qa.w); a[7] = bf_hi(qa.w);
            b[0] = bf_lo(qb.x); b[1] = bf_hi(qb.x); b[2] = bf_lo(qb.y); b[3] = bf_hi(qb.y); b[4] = bf_lo(qb.z); b[5] = bf_hi(qb.z); b[6] = bf_lo(qb.w); b[7] = bf_hi(qb.w);
#pragma unroll
            for (int k = 0; k < 8; ++k) { const float y = w0[k] * p2[k] + w1[k] * p1[k] + w2[k] * a[k]; o[k] = (ACT == 1 ? gelu_tanh(y) : y) * b[k]; p2[k] = p1[k]; p1[k] = a[k]; }
            u32x4 ov; ov.x = pk2(o[0], o[1]); ov.y = pk2(o[2], o[3]); ov.z = pk2(o[4], o[5]); ov.w = pk2(o[6], o[7]);
            *(u32x4*)(O + (size_t)r * C + c) = ov;
            float* so = nullptr;
            if (prompt) { const int t = t0 + i; if (t >= SEQ - 2) so = out_p + ((size_t)bb * 2 + (t - (SEQ - 2))) * C + c; }
            else { const int tt = i & 3; if (tt >= 2) so = out_s + ((size_t)((r - MP) >> 2) * 2 + (tt - 2)) * C + c; }
            if (so) { *(f32x4*)so = (f32x4){a[0], a[1], a[2], a[3]}; *(f32x4*)(so + 4) = (f32x4){a[4], a[5], a[6], a[7]}; }
        }
    }
}

__device__ __forceinline__ void p_gate(Frame& F) {
    const bf16_t* U = (const bf16_t*)(F.ws + WS_U); const bf16_t* V = (const bf16_t*)(F.ws + WS_V); const bf16_t* BG = (const bf16_t*)(F.ws + WS_BG); const bf16_t* P = (const bf16_t*)(F.ws + WS_P);
    bf16_t* YA = (bf16_t*)(F.ws + WS_YA); bf16_t* YB = (bf16_t*)(F.ws + WS_YB); const float* VSS = (const float*)(F.ws + WS_VSS);
    const float* g_v = F.in[11]; const float* w_s = F.in[12]; const float* b_s = F.in[13];
    LAS float* rs = (LAS float*)(F.lds);
    LAS bf16_t* VT = (LAS bf16_t*)(F.lds + 1024);
    constexpr int VTS = 136;
    const int tid = F.tid, lane = F.lane, w = F.wave;
    for (int it = F.vcu; it < (MP / 128) * 16; it += F.G) {
        const int ch = it >> 4, g = it & 15, r0 = ch * 128;
        if (tid < 128) { const f32x4* p = (const f32x4*)(VSS + (size_t)(r0 + tid) * 32); float s = 0.f;
#pragma unroll
            for (int q = 0; q < 8; ++q) { const f32x4 a = p[q]; s += (a[0] + a[1]) + (a[2] + a[3]); }
            rs[tid] = 1.0f / sqrtf(s * (1.0f / DM) + EPS); }
        __syncthreads();
        { const int s_ = tid >> 2, cq = (tid & 3) * 32; const float rsd = rs[s_];
#pragma unroll
          for (int q = 0; q < 4; ++q) { const int c = cq + 8 * q;
              const u32x4 raw = *(const u32x4*)(V + (size_t)(r0 + s_) * DM + g * 128 + c);
              const f32x4 g0 = *(const f32x4*)(g_v + g * 128 + c), g1 = *(const f32x4*)(g_v + g * 128 + c + 4);
              float x[8] = {bf_lo(raw.x), bf_hi(raw.x), bf_lo(raw.y), bf_hi(raw.y), bf_lo(raw.z), bf_hi(raw.z), bf_lo(raw.w), bf_hi(raw.w)};
#pragma unroll
              for (int j = 0; j < 8; ++j) { const float gg = j < 4 ? g0[j & 3] : g1[j & 3]; VT[(c + j) * VTS + s_] = (bf16_t)f2bf(x[j] * rsd * gg); } } }
        __syncthreads();
        f32x4 acc[8];
#pragma unroll
        for (int cb = 0; cb < 8; ++cb) acc[cb] = (f32x4){0.f, 0.f, 0.f, 0.f};
        const int t = 16 * w + (lane & 15);
        for (int kk = 0; kk <= (w >> 1); ++kk) {
            const int s0 = 32 * kk + 8 * (lane >> 4);
            const float* wp = w_s + ((size_t)g * 128 + t) * 128 + s0;
            const f32x4 wa = *(const f32x4*)wp, wb = *(const f32x4*)(wp + 4);
            float wv[8] = {wa[0], wa[1], wa[2], wa[3], wb[0], wb[1], wb[2], wb[3]};
#pragma unroll
            for (int j = 0; j < 8; ++j) if (s0 + j > t) wv[j] = 0.f;
            u32x4 bw; bw.x = pk2(wv[0], wv[1]); bw.y = pk2(wv[2], wv[3]); bw.z = pk2(wv[4], wv[5]); bw.w = pk2(wv[6], wv[7]);
            const bf16x8 bfrag = __builtin_bit_cast(bf16x8, bw);
#pragma unroll
            for (int cb = 0; cb < 8; ++cb) {
                const bf16x8 afrag = *(const LAS bf16x8*)(VT + (16 * cb + (lane & 15)) * VTS + s0);
                acc[cb] = __builtin_amdgcn_mfma_f32_16x16x32_bf16(afrag, bfrag, acc[cb], 0, 0, 0);
            }
        }
        { const int row = r0 + t; const float bsv = b_s[g * 128 + t];
#pragma unroll
          for (int cb = 0; cb < 8; ++cb) { const int col = g * 128 + 16 * cb + 4 * (lane >> 4);
              const u32x2 uu = *(const u32x2*)(U + (size_t)row * DM + col);
              u32x2 o; o.x = pk2(bf_lo(uu.x) * (acc[cb][0] + bsv), bf_hi(uu.x) * (acc[cb][1] + bsv)); o.y = pk2(bf_lo(uu.y) * (acc[cb][2] + bsv), bf_hi(uu.y) * (acc[cb][3] + bsv));
              *(u32x2*)(YA + (size_t)row * DM + col) = o; } }
        __syncthreads();
    }
    conv_gate<0>(F, P, BG, YB, DM, F.in[14], F.in[4], F.out + O_CBP, F.out + O_CBS);
    for (int it = F.vcu; it < DB / 2; it += F.G) {
        const int sb = it * 2 + (tid >> 8), c = (tid & 255) * 8, rb = MP + sb * 4, g = c >> 7;
        if (tid < 8) { const int row = MP + it * 8 + tid; const f32x4* p = (const f32x4*)(VSS + (size_t)row * 32); float s = 0.f;
#pragma unroll
            for (int q = 0; q < 8; ++q) { const f32x4 a = p[q]; s += (a[0] + a[1]) + (a[2] + a[3]); }
            rs[tid] = 1.0f / sqrtf(s * (1.0f / DM) + EPS); }
        __syncthreads();
        float vn[4][8];
        const f32x4 g0 = *(const f32x4*)(g_v + c), g1 = *(const f32x4*)(g_v + c + 4);
#pragma unroll
        for (int tt = 0; tt < 4; ++tt) { const float rsd = rs[(tid >> 8) * 4 + tt];
            const u32x4 raw = *(const u32x4*)(V + (size_t)(rb + tt) * DM + c);
            float x[8] = {bf_lo(raw.x), bf_hi(raw.x), bf_lo(raw.y), bf_hi(raw.y), bf_lo(raw.z), bf_hi(raw.z), bf_lo(raw.w), bf_hi(raw.w)};
#pragma unroll
            for (int j = 0; j < 8; ++j) vn[tt][j] = x[j] * rsd * (j < 4 ? g0[j & 3] : g1[j & 3]);
            float* cv = F.out + O_CV + ((size_t)sb * 4 + tt) * DM + c;
            *(f32x4*)cv = (f32x4){vn[tt][0], vn[tt][1], vn[tt][2], vn[tt][3]}; *(f32x4*)(cv + 4) = (f32x4){vn[tt][4], vn[tt][5], vn[tt][6], vn[tt][7]}; }
#pragma unroll
        for (int tt = 0; tt < 4; ++tt) {
            float sacc[8]; const float bsv = b_s[g * 128 + tt];
#pragma unroll
            for (int j = 0; j < 8; ++j) sacc[j] = bsv;
#pragma unroll
            for (int ss = 0; ss < 4; ++ss) if (ss <= tt) { const float ww = w_s[((size_t)g * 128 + tt) * 128 + ss];
#pragma unroll
                for (int j = 0; j < 8; ++j) sacc[j] += ww * vn[ss][j]; }
            const u32x4 uu = *(const u32x4*)(U + (size_t)(rb + tt) * DM + c);
            u32x4 o; o.x = pk2(bf_lo(uu.x) * sacc[0], bf_hi(uu.x) * sacc[1]); o.y = pk2(bf_lo(uu.y) * sacc[2], bf_hi(uu.y) * sacc[3]);
            o.z = pk2(bf_lo(uu.z) * sacc[4], bf_hi(uu.z) * sacc[5]); o.w = pk2(bf_lo(uu.w) * sacc[6], bf_hi(uu.w) * sacc[7]);
            *(u32x4*)(YA + (size_t)(rb + tt) * DM + c) = o; }
        __syncthreads();
    }
}

__device__ __forceinline__ void p_x1h2(Frame& F) {
    const int gw = F.vcu * NWAVES + F.wave, NGW = F.G * NWAVES;
    const bf16_t* T = (const bf16_t*)(F.ws + WS_T); bf16_t* H2 = (bf16_t*)(F.ws + WS_H2); const float* MOD = (const float*)(F.ws + WS_MOD);
    const float* g_post = F.in[9]; const float* g_pre2 = F.in[18];
    for (int r = gw; r < M; r += NGW) {
        const float* xrow = r < MP ? F.in[0] + (size_t)r * DM : F.in[1] + (size_t)(r - MP) * DM;
        const int bidx = r < MP ? r / SEQ : NB + (r - MP) / DS;
        const float* mod = MOD + (size_t)bidx * NMODC;
        float tv[4][8]; float s = 0.f;
#pragma unroll
        for (int j = 0; j < 4; ++j) { const u32x4 raw = *(const u32x4*)(T + (size_t)r * DM + 8 * F.lane + 512 * j);
            tv[j][0] = bf_lo(raw.x); tv[j][1] = bf_hi(raw.x); tv[j][2] = bf_lo(raw.y); tv[j][3] = bf_hi(raw.y); tv[j][4] = bf_lo(raw.z); tv[j][5] = bf_hi(raw.z); tv[j][6] = bf_lo(raw.w); tv[j][7] = bf_hi(raw.w);
#pragma unroll
            for (int k = 0; k < 8; ++k) s += tv[j][k] * tv[j][k]; }
        const float rstdT = 1.0f / sqrtf(wave_sum(s) * (1.0f / DM) + EPS);
        float s1 = 0.f;
#pragma unroll
        for (int j = 0; j < 4; ++j) { const int c = 8 * F.lane + 512 * j;
#pragma unroll
            for (int h = 0; h < 2; ++h) { const f32x4 xv = *(const f32x4*)(xrow + c + 4 * h), gp = *(const f32x4*)(g_post + c + 4 * h), gt = *(const f32x4*)(mod + 2 * DM + c + 4 * h);
                f32x4 x1;
#pragma unroll
                for (int k = 0; k < 4; ++k) { x1[k] = xv[k] + gt[k] * (tv[j][4 * h + k] * rstdT * gp[k]); tv[j][4 * h + k] = x1[k]; s1 += x1[k] * x1[k]; }
                *(f32x4*)(F.out + O_Y + (size_t)r * DM + c + 4 * h) = x1; } }
        const float rstd1 = 1.0f / sqrtf(wave_sum(s1) * (1.0f / DM) + EPS);
#pragma unroll
        for (int j = 0; j < 4; ++j) { const int c = 8 * F.lane + 512 * j; float h2[8];
#pragma unroll
            for (int h = 0; h < 2; ++h) { const f32x4 gp = *(const f32x4*)(g_pre2 + c + 4 * h), sh = *(const f32x4*)(mod + 3 * DM + c + 4 * h), sc = *(const f32x4*)(mod + 4 * DM + c + 4 * h);
#pragma unroll
                for (int k = 0; k < 4; ++k) h2[4 * h + k] = tv[j][4 * h + k] * rstd1 * gp[k] * (1.0f + sc[k]) + sh[k]; }
            u32x4 o; o.x = pk2(h2[0], h2[1]); o.y = pk2(h2[2], h2[3]); o.z = pk2(h2[4], h2[5]); o.w = pk2(h2[6], h2[7]);
            *(u32x4*)(H2 + (size_t)r * DM + c) = o; }
    }
}

__device__ __forceinline__ void p_final(Frame& F) {
    const int gw = F.vcu * NWAVES + F.wave, NGW = F.G * NWAVES;
    const bf16_t* Fb = (const bf16_t*)(F.ws + WS_F); const float* MOD = (const float*)(F.ws + WS_MOD); const float* g_post = F.in[19];
    for (int r = gw; r < M; r += NGW) {
        const int bidx = r < MP ? r / SEQ : NB + (r - MP) / DS;
        const float* mod = MOD + (size_t)bidx * NMODC;
        float tv[4][8]; float s = 0.f;
#pragma unroll
        for (int j = 0; j < 4; ++j) { const u32x4 raw = *(const u32x4*)(Fb + (size_t)r * DM + 8 * F.lane + 512 * j);
            tv[j][0] = bf_lo(raw.x); tv[j][1] = bf_hi(raw.x); tv[j][2] = bf_lo(raw.y); tv[j][3] = bf_hi(raw.y); tv[j][4] = bf_lo(raw.z); tv[j][5] = bf_hi(raw.z); tv[j][6] = bf_lo(raw.w); tv[j][7] = bf_hi(raw.w);
#pragma unroll
            for (int k = 0; k < 8; ++k) s += tv[j][k] * tv[j][k]; }
        const float rstd = 1.0f / sqrtf(wave_sum(s) * (1.0f / DM) + EPS);
#pragma unroll
        for (int j = 0; j < 4; ++j) { const int c = 8 * F.lane + 512 * j;
#pragma unroll
            for (int h = 0; h < 2; ++h) { float* yp = F.out + O_Y + (size_t)r * DM + c + 4 * h;
                const f32x4 xv = *(const f32x4*)yp, gp = *(const f32x4*)(g_post + c + 4 * h), gt = *(const f32x4*)(mod + 5 * DM + c + 4 * h);
                f32x4 y;
#pragma unroll
                for (int k = 0; k < 4; ++k) y[k] = xv[k] + gt[k] * (tv[j][4 * h + k] * rstd * gp[k]);
                *(f32x4*)yp = y; } }
    }
}

__global__ void __launch_bounds__(NWAVES * 64, 2) fwd_megakernel(Args args) {
    extern __shared__ __attribute__((aligned(16))) unsigned char lds[];
    Frame F;
    F.lds = (LAS unsigned char*)lds;
    F.tid = threadIdx.x; F.lane = F.tid & 63; F.wave = __builtin_amdgcn_readfirstlane(F.tid >> 6);
    F.G = gridDim.x; { const int bx = blockIdx.x; F.vcu = (F.G % 8 == 0) ? (bx % 8) * (F.G / 8) + bx / 8 : bx; }
    F.in = args.in; F.out = args.out; F.ws = args.ws;
    unsigned char* ws = args.ws;
    volatile LAS unsigned* MISC = (volatile LAS unsigned*)(F.lds + MISC_OFF);
    for (int u = F.tid; u < (LDS_BYTES - LDSCTL_OFF) / 4; u += NWAVES * 64) ((LAS unsigned*)(F.lds + LDSCTL_OFF))[u] = 0u;
    __syncthreads();
    XcdBarrier bar; bar.bar = (unsigned*)(ws + WS_CTL) + CW_BAR; bar.x = 0; bar.st = nullptr;
    if (N_LAUNCHES == 1) bar = xcd_barrier_post((unsigned*)(ws + WS_CTL) + CW_BAR, MISC + 8);
    const int lo = args.ph_lo, hi = args.ph_hi;
#define IN(k) (lo <= (k) && (k) < hi)
#define SEAM(k) do { if (IN(k) && IN((k) + 1)) xcd_barrier(bar); } while (0)
    using namespace pg8;
    LAS unsigned char* ring = F.lds + RING_OFF;
    const int cid = (int)blockIdx.x;

    if (IN(0)) { p0_prologue(F); } SEAM(0);
    if (IN(1)) {
        sg::EpiF32B E{(float*)(ws + WS_MOD), NMODC, F.in[7]};
        for (int u = F.vcu; u < 3 * (NMODC / 64); u += F.G) { const int pn = u / 3, pmr = u % 3;
            sg::small_gemm(ring, (const bf16_t*)(ws + WS_S), (const bf16_t*)(ws + WS_WADA), nullptr, nullptr, DM, DM, DM, 1, 64 * pmr, 64 * pn, E); }
    } SEAM(1);
    if (IN(2)) { p_h1(F); } SEAM(2);
    if (IN(3)) {
        Ptrs g{(const bf16_t*)(ws + WS_H1), (const bf16_t*)(ws + WS_WIN), nullptr, nullptr, DM, DM};
        StaticOrder S; S.init(M / 256, INW / 256, F.G, cid, 1);
        EpiIn E{(bf16_t*)(ws + WS_U), (bf16_t*)(ws + WS_V), (bf16_t*)(ws + WS_BG), (bf16_t*)(ws + WS_P), (bf16_t*)(ws + WS_SGA), (bf16_t*)(ws + WS_SGB), (float*)(ws + WS_VSS)};
        gemm_phase<EpiIn, StaticOrder, K_ALIGN, K_SP2>(ring, g, DM, S, E);
    } SEAM(3);
    if (IN(4)) { p_gate(F); } SEAM(4);
    if (IN(5)) {
        Ptrs g{(const bf16_t*)(ws + WS_YB), (const bf16_t*)(ws + WS_WB), (const bf16_t*)(ws + WS_YA), (const bf16_t*)(ws + WS_WA), DM, DM};
        StaticOrder S; S.init(MP / 256, DM / 256, F.G, cid, 2);
        EpiOut E{(const bf16_t*)(ws + WS_SGA), (const bf16_t*)(ws + WS_SGB), (bf16_t*)(ws + WS_MERGED)};
        gemm_phase<EpiOut, StaticOrder, K_ALIGN, K_SP2>(ring, g, DM, S, E);
        sg::EpiOutS Es{(const bf16_t*)(ws + WS_SGA), (const bf16_t*)(ws + WS_SGB), (bf16_t*)(ws + WS_MERGED)};
        for (int u = cid; u < (MS / 64) * (DM / 64); u += F.G)
            sg::small_gemm(ring, g.A0, g.B0, g.A1, g.B1, DM, DM, DM, 2, MP + 64 * (u / (DM / 64)), 64 * (u % (DM / 64)), Es);
    } SEAM(5);
    if (IN(6)) {
        Ptrs g{(const bf16_t*)(ws + WS_MERGED), (const bf16_t*)(ws + WS_WO), nullptr, nullptr, DM, DM};
        StaticOrder S; S.init(MP / 256, DM / 256, F.G, cid, 1);
        EpiBf16 E{(bf16_t*)(ws + WS_T), DM};
        gemm_phase<EpiBf16, StaticOrder, K_ALIGN, K_SP2>(ring, g, DM, S, E);
        sg::EpiSum Es{(bf16_t*)(ws + WS_T), DM};
        for (int u = cid; u < (MS / 64) * (DM / 64); u += F.G)
            sg::small_gemm(ring, g.A0, g.B0, nullptr, nullptr, DM, DM, DM, 1, MP + 64 * (u / (DM / 64)), 64 * (u % (DM / 64)), Es);
    } SEAM(6);
    if (IN(7)) { p_x1h2(F); } SEAM(7);
    if (IN(8)) {
        Ptrs g{(const bf16_t*)(ws + WS_H2), (const bf16_t*)(ws + WS_WUP), nullptr, nullptr, DM, DM};
        StaticOrder S; S.init(M / 256, 2 * DFF / 256, F.G, cid, 1);
        EpiUp E{(bf16_t*)(ws + WS_AUP), (bf16_t*)(ws + WS_BUP)};
        gemm_phase<EpiUp, StaticOrder, K_ALIGN, K_SP2>(ring, g, DM, S, E);
    } SEAM(8);
    if (IN(9)) { conv_gate<1>(F, (const bf16_t*)(ws + WS_AUP), (const bf16_t*)(ws + WS_BUP), (bf16_t*)(ws + WS_G), DFF, F.in[21], F.in[5], F.out + O_CFP, F.out + O_CFS); } SEAM(9);
    if (IN(10)) {
        Ptrs g{(const bf16_t*)(ws + WS_G), (const bf16_t*)(ws + WS_WD), nullptr, nullptr, DFF, DFF};
        StaticOrder S; S.init(MP / 256, DM / 256, F.G, cid, 1);
        EpiBf16 E{(bf16_t*)(ws + WS_F), DM};
        gemm_phase<EpiBf16, StaticOrder, K_ALIGN, K_SP2>(ring, g, DFF, S, E);
        sg::EpiSum Es{(bf16_t*)(ws + WS_F), DM};
        for (int u = cid; u < (MS / 64) * (DM / 64); u += F.G)
            sg::small_gemm(ring, g.A0, g.B0, nullptr, nullptr, DFF, DFF, DFF, 1, MP + 64 * (u / (DM / 64)), 64 * (u % (DM / 64)), Es);
    } SEAM(10);
    if (IN(11)) { p_final(F); }
#undef IN
#undef SEAM
}

extern "C" void kernel_launch(void* const* d_in, const int* in_sizes, int n_in, void* d_out, int out_size, void* d_ws, size_t ws_size, hipStream_t stream) {
    static int grid = 0;
    if (grid == 0) {
        if (n_in != 23 || out_size != (int)O_END || ws_size < WS_END) { fprintf(stderr, "kernel_launch: unexpected shapes: n_in %d out %d ws %zu (need %zu)\n", n_in, out_size, ws_size, (size_t)WS_END); grid = -1; return; }
        int dev = 0, cus = 0, per_cu = 0;
        if (hipGetDevice(&dev) != hipSuccess || hipDeviceGetAttribute(&cus, hipDeviceAttributeMultiprocessorCount, dev) != hipSuccess) { grid = -1; return; }
        if (hipFuncSetAttribute((const void*)fwd_megakernel, hipFuncAttributeMaxDynamicSharedMemorySize, LDS_BYTES) != hipSuccess) { fprintf(stderr, "kernel_launch: hipFuncSetAttribute failed\n"); grid = -1; return; }
        if (hipOccupancyMaxActiveBlocksPerMultiprocessor(&per_cu, (const void*)fwd_megakernel, NWAVES * 64, LDS_BYTES) != hipSuccess || per_cu < 1) { fprintf(stderr, "kernel_launch: occupancy query says %d blocks per CU\n", per_cu); (void)hipGetLastError(); grid = -1; return; }
        grid = cus;
    }
    if (grid < 0) return;
    (void)hipMemsetAsync((char*)d_ws + WS_CTL, 0, CTL_ZERO_BYTES, stream);
    Args a{};
    for (int i = 0; i < 23; ++i) a.in[i] = (const float*)d_in[i];
    a.out = (float*)d_out; a.ws = (unsigned char*)d_ws;
    if (N_LAUNCHES == 1) {
        a.ph_lo = 0; a.ph_hi = NPHASES; a.li = 0;
        hipLaunchKernelGGL(fwd_megakernel, dim3(grid), dim3(NWAVES * 64), LDS_BYTES, stream, a);
    } else {
        for (int li = 0; li < NPHASES; ++li) { a.ph_lo = li; a.ph_hi = li + 1; a.li = li;
            hipLaunchKernelGGL(fwd_megakernel, dim3(grid), dim3(NWAVES * 64), LDS_BYTES, stream, a); }
    }
    const hipError_t le = hipPeekAtLastError();
    if (le != hipSuccess) fprintf(stderr, "kernel_launch: launch failed: %s\n", hipGetErrorName(le));
}
```

```cpp
#include <hip/hip_runtime.h>
#include <cstdio>
#include <cstdint>

#define LAS __attribute__((address_space(3)))
#define GAS __attribute__((address_space(1)))
typedef unsigned short bf16_t;
typedef short bf16x8 __attribute__((ext_vector_type(8)));
typedef float f32x4 __attribute__((ext_vector_type(4)));
typedef float f32x2 __attribute__((ext_vector_type(2)));
typedef unsigned u32x4 __attribute__((ext_vector_type(4)));
typedef unsigned u32x2 __attribute__((ext_vector_type(2)));

constexpr int DM = 2048, NB = 4, SEQ = 2048, DB = 128, DS = 4, DFF = 5632, INW = 14336, NMODC = 6 * DM;
constexpr int MP = NB * SEQ, MS = DB * DS, M = MP + MS;
constexpr int NBIDX = NB + DB;
constexpr float EPS = 1e-6f;

constexpr size_t MiB = 1u << 20;
constexpr size_t WS_CTL = 0, CTL_ZERO_BYTES = 1 * MiB;
constexpr size_t WS_S = 1 * MiB;
constexpr size_t WS_MOD = 2 * MiB;
constexpr size_t WS_VSS = 14 * MiB;
constexpr size_t WS_WIN = 16 * MiB;
constexpr size_t WS_WB = 72 * MiB, WS_WA = 80 * MiB, WS_WO = 88 * MiB;
constexpr size_t WS_WUP = 96 * MiB;
constexpr size_t WS_WD = 140 * MiB;
constexpr size_t WS_R1 = 162 * MiB;
constexpr size_t SLOT = 34 * MiB;
constexpr size_t WS_H1 = WS_R1, WS_YA = WS_R1, WS_H2 = WS_R1, WS_YB = WS_R1 + SLOT, WS_WADA = WS_R1;
constexpr size_t WS_R2 = 230 * MiB;
constexpr size_t WS_U = WS_R2, WS_V = WS_R2 + SLOT, WS_BG = WS_R2 + 2 * SLOT, WS_P = WS_R2 + 3 * SLOT, WS_SGA = WS_R2 + 4 * SLOT, WS_SGB = WS_R2 + 5 * SLOT;
constexpr size_t WS_MERGED = WS_R2, WS_T = WS_R2 + SLOT;
constexpr size_t WS_G = WS_R2;
constexpr size_t WS_SA = 324 * MiB;
constexpr size_t WS_SB = 335 * MiB;
constexpr size_t WS_SAS = 341 * MiB, WS_SBS = 352 * MiB;
constexpr size_t WS_F = WS_R1 + SLOT;
constexpr size_t WS_END = 434 * MiB;
static_assert(WS_G + (size_t)M * DFF * 2 <= WS_SA && WS_SA + (size_t)512 * DFF * 4 <= WS_SB && WS_SB + (size_t)256 * DFF * 4 <= WS_SAS && WS_SAS + (size_t)512 * DFF * 4 <= WS_SBS && WS_SBS + (size_t)512 * DFF * 4 <= WS_END, "ws map");
static_assert((size_t)M * DM * 2 == SLOT, "slot size");

constexpr size_t O_Y = 0, O_CBP = (size_t)M * DM, O_CBS = O_CBP + (size_t)NB * 2 * DM, O_CFP = O_CBS + (size_t)DB * 2 * DM,
                 O_CFS = O_CFP + (size_t)NB * 2 * DFF, O_CV = O_CFS + (size_t)DB * 2 * DFF, O_END = O_CV + (size_t)MS * DM;

namespace pg8 {
constexpr int BM = 256, BK = 64, HALF = 128, HTB = HALF * BK * 2, STAGE_BYTES = 8 * HTB, NXCD = 8, WGM = 8;
__host__ __device__ __forceinline__ int lds_byte(int r, int c) { const int st = (r >> 4) * 2 + (c >> 5), rr = r & 15, cc = c & 31, ob = rr * 64 + cc * 2; return st * 1024 + (ob ^ (((ob >> 9) & 1) << 5)); }
__host__ __device__ __forceinline__ void stage_rc(int b, int& R, int& C) { const int st = b / 1024, sb = b % 1024, swz = sb ^ (((sb >> 9) & 1) << 5); R = (st >> 1) * 16 + swz / 64; C = (st & 1) * 32 + (swz % 64) / 2; }
__host__ __device__ __forceinline__ int perm32(int rho) { const int n = rho >> 4, i = rho & 15; return 8 * (i >> 2) + 4 * n + (i & 3); }

struct Unit { int pm, pn, part; };

struct StaticOrder {
    int nM, nN, nwg, G, c, parts;
    __device__ void init(int nM_, int nN_, int G_, int c_, int parts_) { nM = nM_; nN = nN_; nwg = nM * nN; G = G_; c = c_; parts = parts_; }
    __device__ bool next(int i, Unit& u) const {
        const int ti = (parts == 2) ? (i >> 1) : i; u.part = (parts == 2) ? (i & 1) : 0;
        const long L = (long)ti * G + c; if (L >= nwg) return false;
        int wgid = (int)L; { const int q = nwg / NXCD, r = nwg % NXCD, xcd = wgid % NXCD, off = wgid / NXCD; wgid = (xcd < r ? xcd * (q + 1) : r * (q + 1) + (xcd - r) * q) + off; }
        const int nig = WGM * nN, gid = wgid / nig, fm = gid * WGM, gsz = (nM - fm) < WGM ? (nM - fm) : WGM;
        u.pm = fm + ((wgid % nig) % gsz); u.pn = (wgid % nig) / gsz; return true;
    }
};

struct Ptrs {
    const bf16_t* A0; const bf16_t* B0; const bf16_t* A1; const bf16_t* B1; int lda, ldb;
    __device__ __forceinline__ const char* a(const Unit& u) const { return (const char*)((u.part ? A1 : A0) + (size_t)u.pm * BM * lda); }
    __device__ __forceinline__ const char* b(const Unit& u) const { return (const char*)((u.part ? B1 : B0) + (size_t)u.pn * BM * ldb); }
};

__device__ __forceinline__ unsigned cvt_pk_bf16(float lo, float hi) { unsigned r; asm volatile("v_cvt_pk_bf16_f32 %0, %1, %2" : "=v"(r) : "v"(lo), "v"(hi)); return r; }
__device__ __forceinline__ float bf_lo(unsigned w) { return __builtin_bit_cast(float, w << 16); }
__device__ __forceinline__ float bf_hi(unsigned w) { return __builtin_bit_cast(float, w & 0xffff0000u); }
__device__ __forceinline__ float sigmoidf_(float x) { return __builtin_amdgcn_rcpf(1.0f + __builtin_amdgcn_exp2f(-1.4426950409f * x)); }

typedef f32x4 Acc[2][2][4][2];

__device__ __forceinline__ u32x4 pack8(const f32x4& v0, const f32x4& v1) { u32x4 w; w.x = cvt_pk_bf16(v0[0], v0[1]); w.y = cvt_pk_bf16(v0[2], v0[3]); w.z = cvt_pk_bf16(v1[0], v1[1]); w.w = cvt_pk_bf16(v1[2], v1[3]); return w; }

struct EpiF32 {
    static constexpr bool PERM = false;
    float* C; int ldc; const float* bias;
    __device__ __forceinline__ bool keep(const Unit&) const { return false; }
    __device__ __forceinline__ void operator()(Acc& acc, const Unit& u, int wr, int wc, int fr, int fq) const {
        const int row0 = u.pm * BM + wr * 64 + fr, col0 = u.pn * BM + wc * 32 + 4 * fq;
        f32x4 bv[2][2];
#pragma unroll
        for (int bj = 0; bj < 2; ++bj)
#pragma unroll
            for (int n = 0; n < 2; ++n) bv[bj][n] = *(const f32x4*)(bias + col0 + bj * HALF + n * 16);
#pragma unroll
        for (int ai = 0; ai < 2; ++ai)
#pragma unroll
            for (int m = 0; m < 4; ++m) { float* rowp = C + (size_t)(row0 + ai * HALF + m * 16) * ldc + col0;
#pragma unroll
                for (int bj = 0; bj < 2; ++bj)
#pragma unroll
                    for (int n = 0; n < 2; ++n) *(f32x4*)(rowp + bj * HALF + n * 16) = acc[ai][bj][m][n] + bv[bj][n]; }
    }
};

struct EpiBf16 {
    static constexpr bool PERM = true;
    bf16_t* O; int ldc;
    __device__ __forceinline__ bool keep(const Unit&) const { return false; }
    __device__ __forceinline__ void operator()(Acc& acc, const Unit& u, int wr, int wc, int fr, int fq) const {
        const int row0 = u.pm * BM + wr * 64 + fr, col0 = u.pn * BM + wc * 32 + 8 * fq;
#pragma unroll
        for (int ai = 0; ai < 2; ++ai)
#pragma unroll
            for (int m = 0; m < 4; ++m) { bf16_t* rowp = O + (size_t)(row0 + ai * HALF + m * 16) * ldc + col0;
#pragma unroll
                for (int bj = 0; bj < 2; ++bj) *(u32x4*)(rowp + bj * HALF) = pack8(acc[ai][bj][m][0], acc[ai][bj][m][1]); }
    }
};

struct EpiIn {
    static constexpr bool PERM = true;
    bf16_t *U, *V, *BG, *P, *SGA, *SGB; float* VSS;
    __device__ __forceinline__ bool keep(const Unit&) const { return false; }
    __device__ __forceinline__ void operator()(Acc& acc, const Unit& u, int wr, int wc, int fr, int fq) const {
        const int row0 = u.pm * BM + wr * 64 + fr; const int pn = u.pn;
        if (pn >= 24 && pn < 40) {
            const int col0 = (pn - 24) * HALF + wc * 32 + 8 * fq;
#pragma unroll
            for (int ai = 0; ai < 2; ++ai)
#pragma unroll
                for (int m = 0; m < 4; ++m) {
                    const f32x4 p0 = acc[ai][0][m][0] * acc[ai][1][m][0], p1 = acc[ai][0][m][1] * acc[ai][1][m][1];
                    *(u32x4*)(P + (size_t)(row0 + ai * HALF + m * 16) * DM + col0) = pack8(p0, p1); }
            return;
        }
        bf16_t* O; int ct; bool sig = false, ss = false;
        if (pn < 8) { O = U; ct = pn; } else if (pn < 16) { O = V; ct = pn - 8; ss = true; } else if (pn < 24) { O = BG; ct = pn - 16; }
        else if (pn < 48) { O = SGA; ct = pn - 40; sig = true; } else { O = SGB; ct = pn - 48; sig = true; }
        const int col0 = ct * BM + wc * 32 + 8 * fq;
#pragma unroll
        for (int ai = 0; ai < 2; ++ai)
#pragma unroll
            for (int m = 0; m < 4; ++m) {
                const int row = row0 + ai * HALF + m * 16; bf16_t* rowp = O + (size_t)row * DM + col0;
                if (ss) { float s = 0.f;
#pragma unroll
                    for (int bj = 0; bj < 2; ++bj)
#pragma unroll
                        for (int n = 0; n < 2; ++n) { const f32x4 x = acc[ai][bj][m][n]; s += (x[0] * x[0] + x[1] * x[1]) + (x[2] * x[2] + x[3] * x[3]); }
                    s += __shfl_xor(s, 16); s += __shfl_xor(s, 32);
                    if (fq == 0) VSS[(size_t)row * 32 + ct * 4 + wc] = s; }
#pragma unroll
                for (int bj = 0; bj < 2; ++bj) { f32x4 v0 = acc[ai][bj][m][0], v1 = acc[ai][bj][m][1];
                    if (sig) {
#pragma unroll
                        for (int i = 0; i < 4; ++i) { v0[i] = sigmoidf_(v0[i]); v1[i] = sigmoidf_(v1[i]); } }
                    *(u32x4*)(rowp + bj * HALF) = pack8(v0, v1); } }
    }
};

struct EpiOut {
    static constexpr bool PERM = true;
    const bf16_t *SGA, *SGB; bf16_t* O;
    __device__ __forceinline__ bool keep(const Unit& u) const { return u.part == 0; }
    __device__ __forceinline__ void operator()(Acc& acc, const Unit& u, int wr, int wc, int fr, int fq) const {
        const int row0 = u.pm * BM + wr * 64 + fr, col0 = u.pn * BM + wc * 32 + 8 * fq;
#pragma unroll
        for (int ai = 0; ai < 2; ++ai)
#pragma unroll
            for (int m = 0; m < 4; ++m) { const size_t off = (size_t)(row0 + ai * HALF + m * 16) * DM + col0;
#pragma unroll
                for (int bj = 0; bj < 2; ++bj) {
                    const u32x4 a = *(const u32x4*)(SGA + off + bj * HALF);
                    f32x4 a0 = {bf_lo(a.x), bf_hi(a.x), bf_lo(a.y), bf_hi(a.y)}, a1 = {bf_lo(a.z), bf_hi(a.z), bf_lo(a.w), bf_hi(a.w)};
                    if (u.part == 0) {
                        const u32x4 b = *(const u32x4*)(SGB + off + bj * HALF);
                        const f32x4 b0 = {bf_lo(b.x), bf_hi(b.x), bf_lo(b.y), bf_hi(b.y)}, b1 = {bf_lo(b.z), bf_hi(b.z), bf_lo(b.w), bf_hi(b.w)};
#pragma unroll
                        for (int i = 0; i < 4; ++i) { acc[ai][bj][m][0][i] *= b0[i] * __builtin_amdgcn_rcpf(a0[i]); acc[ai][bj][m][1][i] *= b1[i] * __builtin_amdgcn_rcpf(a1[i]); }
                    } else {
                        *(u32x4*)(O + off + bj * HALF) = pack8(acc[ai][bj][m][0] * a0, acc[ai][bj][m][1] * a1);
                    } }
                asm volatile("" ::: "memory"); }
    }
};

__device__ __forceinline__ float gelu_fast(float x) { const float z = x + 0.044715f * x * x * x; return x * __builtin_amdgcn_rcpf(1.0f + __builtin_amdgcn_exp2f(-2.3022082f * z)); }
__device__ __forceinline__ float lane_get(float v, int addr4) { return __builtin_bit_cast(float, __builtin_amdgcn_ds_bpermute(addr4, __builtin_bit_cast(int, v))); }
struct EpiUpF {
    static constexpr bool PERM = true;
    bf16_t* G; float *SA, *SB, *SAS, *SBS; const float* cw;
    __device__ __forceinline__ bool keep(const Unit&) const { return false; }
    __device__ __forceinline__ void operator()(Acc& acc, const Unit& u, int wr, int wc, int fr, int fq) const {
        const int col0 = u.pn * HALF + wc * 32 + 8 * fq;
        if (u.pm >= MP / BM) {
#pragma unroll
            for (int ai = 0; ai < 2; ++ai)
#pragma unroll
                for (int m = 0; m < 4; ++m) { const size_t off = (size_t)(u.pm * BM - MP + ai * HALF + wr * 64 + m * 16 + fr) * DFF + col0;
                    *(f32x4*)(SAS + off) = acc[ai][0][m][0]; *(f32x4*)(SAS + off + 4) = acc[ai][0][m][1];
                    *(f32x4*)(SBS + off) = acc[ai][1][m][0]; *(f32x4*)(SBS + off + 4) = acc[ai][1][m][1]; }
            return;
        }
        f32x4 w0[2], w1[2], w2[2];
#pragma unroll
        for (int n = 0; n < 2; ++n) { w0[n] = *(const f32x4*)(cw + col0 + 4 * n); w1[n] = *(const f32x4*)(cw + DFF + col0 + 4 * n); w2[n] = *(const f32x4*)(cw + 2 * DFF + col0 + 4 * n); }
#pragma unroll
        for (int ai = 0; ai < 2; ++ai) {
            const int rb64 = u.pm * 4 + ai * 2 + wr;
#pragma unroll
            for (int m = 0; m < 4; ++m) {
                f32x4 gv[2];
#pragma unroll
                for (int n = 0; n < 2; ++n) {
                    const f32x4 a = acc[ai][0][m][n], b = acc[ai][1][m][n];
#pragma unroll
                    for (int i = 0; i < 4; ++i) {
                        const float av_ = a[i]; const int ai_ = __builtin_bit_cast(int, av_);
                        int o1 = 0, o2 = 0;
                        if (m > 0) { const float pf_ = acc[ai][0][m > 0 ? m - 1 : 0][n][i]; const int pv = __builtin_bit_cast(int, pf_);
                            o1 = __builtin_amdgcn_update_dpp(0, pv, 0x140, 0xf, 0xf, true);
                            o2 = __builtin_amdgcn_update_dpp(0, o1, 0xB1, 0xf, 0xf, true); }
                        const float p1 = __builtin_bit_cast(float, __builtin_amdgcn_update_dpp(o1, ai_, 0x111, 0xf, 0xf, false));
                        const float p2 = __builtin_bit_cast(float, __builtin_amdgcn_update_dpp(o2, ai_, 0x112, 0xf, 0xf, false));
                        const float y = w0[n][i] * p2 + w1[n][i] * p1 + w2[n][i] * a[i];
                        gv[n][i] = gelu_fast(y) * b[i];
                    }
                }
                const int row = u.pm * BM + ai * HALF + wr * 64 + m * 16 + fr;
                if (!(m == 0 && fr < 2)) *(u32x4*)(G + (size_t)row * DFF + col0) = pack8(gv[0], gv[1]);
                if (m == 0 && fr < 2) { float* pa = SA + (size_t)(rb64 * 4 + 2 + fr) * DFF + col0; float* pb = SB + (size_t)(rb64 * 2 + fr) * DFF + col0;
                    *(f32x4*)pa = acc[ai][0][0][0]; *(f32x4*)(pa + 4) = acc[ai][0][0][1]; *(f32x4*)pb = acc[ai][1][0][0]; *(f32x4*)(pb + 4) = acc[ai][1][0][1]; }
                if (m == 3 && fr >= 14) { float* pa = SA + (size_t)(rb64 * 4 + (fr - 14)) * DFF + col0; *(f32x4*)pa = acc[ai][0][3][0]; *(f32x4*)(pa + 4) = acc[ai][0][3][1]; }
            }
        }
    }
};

template <class Epi, class Sched, bool ALIGN_EPI, bool SP2>
__device__ __forceinline__ void gemm_phase(LAS unsigned char* lds, const Ptrs g, const int K, const Sched& S, const Epi& E) {
    const int tid = threadIdx.x, wid = __builtin_amdgcn_readfirstlane(tid >> 6), lane = tid & 63, wr = wid >> 2, wc = wid & 3, fr = lane & 15, fq = lane >> 4;
    const int nt = K / BK;
    unsigned voffA[2], voffB[2];
#pragma unroll
    for (int i = 0; i < 2; ++i) { int R, C; stage_rc(tid * 16 + i * 8192, R, C); const int Rb = Epi::PERM ? ((R & ~31) + perm32(R & 31)) : R;
        voffA[i] = (unsigned)(R * g.lda + C) * 2u; voffB[i] = (unsigned)(Rb * g.ldb + C) * 2u; }
    const size_t kstep = (size_t)(BK * 2);
    const size_t hstepA = (size_t)HALF * g.lda * 2, hstepB = (size_t)HALF * g.ldb * 2;
    const unsigned ldsw = (unsigned)wid * 1024u;
    const int aoff = lds_byte(wr * 64 + fr, fq * 8), boff = lds_byte(wc * 32 + fr, fq * 8);
#define PG8_SA(b, h) (((b) * 2 + (h)) * HTB)
#define PG8_SB(b, h) ((4 + (b) * 2 + (h)) * HTB)
#define PG8_STAGE(bufoff, gbase, voff) do { _Pragma("unroll") for (int _i = 0; _i < 2; ++_i) \
        __builtin_amdgcn_global_load_lds((const unsigned*)((const char*)(gbase) + (voff)[_i]), (LAS unsigned*)(lds + (bufoff) + ldsw + _i * 8192), 16, 0, 0); } while (0)
#define PG8_LDA(dst, b, h) do { _Pragma("unroll") for (int m = 0; m < 4; ++m) _Pragma("unroll") for (int k = 0; k < 2; ++k) dst[m][k] = *(const LAS bf16x8*)(lds + PG8_SA(b, h) + aoff + m * 2048 + k * 1024); } while (0)
#define PG8_LDB(dst, b, h) do { _Pragma("unroll") for (int n = 0; n < 2; ++n) _Pragma("unroll") for (int k = 0; k < 2; ++k) dst[n][k] = *(const LAS bf16x8*)(lds + PG8_SB(b, h) + boff + n * 2048 + k * 1024); } while (0)
#define PG8_MMA(ai, bj, At, Bt) do { __builtin_amdgcn_s_setprio(1); _Pragma("unroll") for (int m = 0; m < 4; ++m) _Pragma("unroll") for (int n = 0; n < 2; ++n) _Pragma("unroll") for (int k = 0; k < 2; ++k) \
        acc[ai][bj][m][n] = __builtin_amdgcn_mfma_f32_16x16x32_bf16(Bt[n][k], At[m][k], acc[ai][bj][m][n], 0, 0, 0); __builtin_amdgcn_s_setprio(0); } while (0)
#define PG8_WAIT_V(n) asm volatile("s_waitcnt vmcnt(" #n ")" ::: "memory")
#define PG8_WAIT_L(n) asm volatile("s_waitcnt lgkmcnt(" #n ")" ::: "memory")
#define PG8_BAR __builtin_amdgcn_s_barrier()
#define PG8_SCHED __builtin_amdgcn_sched_barrier(0)
    Unit cur, nxt; int ui = 0;
    if (!S.next(0, cur)) return;
    Acc acc;
#pragma unroll
    for (int a = 0; a < 2; ++a)
#pragma unroll
        for (int b = 0; b < 2; ++b)
#pragma unroll
            for (int m = 0; m < 4; ++m)
#pragma unroll
                for (int n = 0; n < 2; ++n) acc[a][b][m][n] = (f32x4){0.f, 0.f, 0.f, 0.f};
    bf16x8 At[4][2], B0[2][2], B1[2][2];
    const char* cA = g.a(cur); const char* cB = g.b(cur);
    if constexpr (SP2) {
        PG8_STAGE(PG8_SB(0, 0), cB, voffB); PG8_STAGE(PG8_SB(0, 1), cB + hstepB, voffB); PG8_STAGE(PG8_SA(0, 0), cA, voffA); PG8_STAGE(PG8_SA(0, 1), cA + hstepA, voffA);
        if (wr == 1) PG8_BAR;
        PG8_WAIT_V(2); PG8_BAR;
        PG8_STAGE(PG8_SB(1, 0), cB + kstep, voffB); PG8_STAGE(PG8_SA(1, 0), cA + kstep, voffA); PG8_STAGE(PG8_SB(1, 1), cB + hstepB + kstep, voffB);
        PG8_WAIT_V(6); PG8_BAR;
    } else {
        PG8_STAGE(PG8_SB(0, 0), cB, voffB); PG8_STAGE(PG8_SA(0, 0), cA, voffA); PG8_STAGE(PG8_SB(0, 1), cB + hstepB, voffB); PG8_STAGE(PG8_SA(0, 1), cA + hstepA, voffA);
        if (wr == 1) PG8_BAR;
        PG8_WAIT_V(4); PG8_BAR;
        PG8_STAGE(PG8_SB(1, 0), cB + kstep, voffB); PG8_STAGE(PG8_SA(1, 0), cA + kstep, voffA); PG8_STAGE(PG8_SB(1, 1), cB + hstepB + kstep, voffB);
        PG8_WAIT_V(6); PG8_BAR;
    }
    for (;;) {
        const bool has_next = S.next(ui + 1, nxt);
        const char* nA = has_next ? g.a(nxt) : cA; const char* nB = has_next ? g.b(nxt) : cB;
        for (int t = 0; t < nt; t += 2) {
            const bool last = (t == nt - 2);
            const char* a1 = cA + (size_t)(t + 1) * kstep;
            const char* a2 = last ? nA : cA + (size_t)(t + 2) * kstep; const char* b2 = last ? nB : cB + (size_t)(t + 2) * kstep;
            const char* a3 = a2 + kstep; const char* b3 = b2 + kstep;
            if constexpr (SP2) {
            PG8_LDB(B0, 0, 0); PG8_LDB(B1, 0, 1); PG8_SCHED; PG8_LDA(At, 0, 0); PG8_STAGE(PG8_SA(1, 1), a1 + hstepA, voffA);
            PG8_WAIT_V(8); PG8_WAIT_L(0); PG8_BAR; PG8_MMA(0, 0, At, B0); PG8_MMA(0, 1, At, B1); PG8_BAR; PG8_SCHED;
            PG8_LDA(At, 0, 1); PG8_STAGE(PG8_SB(0, 0), b2, voffB); PG8_STAGE(PG8_SB(0, 1), b2 + hstepB, voffB); PG8_STAGE(PG8_SA(0, 0), a2, voffA);
            PG8_WAIT_V(8); PG8_WAIT_L(0); PG8_BAR; PG8_MMA(1, 0, At, B0); PG8_MMA(1, 1, At, B1); PG8_BAR; PG8_SCHED;
            PG8_LDB(B0, 1, 0); PG8_LDB(B1, 1, 1); PG8_SCHED; PG8_LDA(At, 1, 0); PG8_STAGE(PG8_SA(0, 1), a2 + hstepA, voffA);
            PG8_WAIT_V(8); PG8_WAIT_L(0); PG8_BAR; PG8_MMA(0, 0, At, B0); PG8_MMA(0, 1, At, B1); PG8_BAR; PG8_SCHED;
            PG8_LDA(At, 1, 1); PG8_STAGE(PG8_SB(1, 0), b3, voffB); PG8_STAGE(PG8_SB(1, 1), b3 + hstepB, voffB); PG8_STAGE(PG8_SA(1, 0), a3, voffA);
            PG8_WAIT_V(8); PG8_WAIT_L(0); PG8_BAR; PG8_MMA(1, 0, At, B0); PG8_MMA(1, 1, At, B1); PG8_BAR; PG8_SCHED;
            } else {
            PG8_LDB(B0, 0, 0); PG8_SCHED; PG8_LDA(At, 0, 0); PG8_STAGE(PG8_SA(1, 1), a1 + hstepA, voffA);
            PG8_WAIT_L(8); PG8_BAR; PG8_WAIT_L(0); PG8_MMA(0, 0, At, B0); PG8_BAR; PG8_SCHED;
            PG8_LDB(B1, 0, 1); PG8_STAGE(PG8_SB(0, 0), b2, voffB);
            PG8_BAR; PG8_WAIT_L(0); PG8_MMA(0, 1, At, B1); PG8_BAR;
            PG8_LDA(At, 0, 1); PG8_STAGE(PG8_SA(0, 0), a2, voffA);
            PG8_BAR; PG8_WAIT_L(0); PG8_MMA(1, 0, At, B0); PG8_BAR; PG8_SCHED;
            PG8_STAGE(PG8_SB(0, 1), b2 + hstepB, voffB);
            PG8_WAIT_V(6); PG8_BAR; PG8_MMA(1, 1, At, B1); PG8_BAR;
            PG8_LDB(B0, 1, 0); PG8_SCHED; PG8_LDA(At, 1, 0); PG8_STAGE(PG8_SA(0, 1), a2 + hstepA, voffA);
            PG8_WAIT_L(8); PG8_BAR; PG8_WAIT_L(0); PG8_MMA(0, 0, At, B0); PG8_BAR; PG8_SCHED;
            PG8_LDB(B1, 1, 1); PG8_STAGE(PG8_SB(1, 0), b3, voffB);
            PG8_BAR; PG8_WAIT_L(0); PG8_MMA(0, 1, At, B1); PG8_BAR;
            PG8_LDA(At, 1, 1); PG8_STAGE(PG8_SA(1, 0), a3, voffA);
            PG8_BAR; PG8_WAIT_L(0); PG8_MMA(1, 0, At, B0); PG8_BAR; PG8_SCHED;
            PG8_STAGE(PG8_SB(1, 1), b3 + hstepB, voffB);
            PG8_WAIT_V(6); PG8_BAR; PG8_MMA(1, 1, At, B1); PG8_BAR;
            }
        }
        if constexpr (ALIGN_EPI) { if (wr == 0) PG8_BAR; }
        E(acc, cur, wr, wc, fr, fq);
        if (!E.keep(cur)) {
#pragma unroll
            for (int a = 0; a < 2; ++a)
#pragma unroll
                for (int b = 0; b < 2; ++b)
#pragma unroll
                    for (int m = 0; m < 4; ++m)
#pragma unroll
                        for (int n = 0; n < 2; ++n) acc[a][b][m][n] = (f32x4){0.f, 0.f, 0.f, 0.f};
        }
        if (!has_next) break;
        cur = nxt; cA = nA; cB = nB; ++ui;
        if constexpr (ALIGN_EPI) { if (wr == 1) PG8_BAR; }
    }
    PG8_WAIT_V(0);
    if constexpr (!ALIGN_EPI) { if (wr == 0) PG8_BAR; }
    PG8_BAR;
#undef PG8_SA
#undef PG8_SB
#undef PG8_STAGE
#undef PG8_LDA
#undef PG8_LDB
#undef PG8_MMA
#undef PG8_WAIT_V
#undef PG8_WAIT_L
#undef PG8_BAR
#undef PG8_SCHED
}
}


namespace sg {
struct EpiSum {
    bf16_t* O; int ldc;
    __device__ __forceinline__ void operator()(int row, int col, const f32x4& s0, const f32x4& s1) const {
        const f32x4 r = s0 + s1; u32x2 o; o.x = pg8::cvt_pk_bf16(r[0], r[1]); o.y = pg8::cvt_pk_bf16(r[2], r[3]);
        *(u32x2*)(O + (size_t)row * ldc + col) = o; }
};
struct EpiOutS {
    const bf16_t *SGA, *SGB; bf16_t* O;
    __device__ __forceinline__ void operator()(int row, int col, const f32x4& s0, const f32x4& s1) const {
        const size_t off = (size_t)row * DM + col; const u32x2 a = *(const u32x2*)(SGA + off), b = *(const u32x2*)(SGB + off);
        const f32x4 av = {pg8::bf_lo(a.x), pg8::bf_hi(a.x), pg8::bf_lo(a.y), pg8::bf_hi(a.y)}, bv = {pg8::bf_lo(b.x), pg8::bf_hi(b.x), pg8::bf_lo(b.y), pg8::bf_hi(b.y)};
        const f32x4 r = av * s1 + bv * s0; u32x2 o; o.x = pg8::cvt_pk_bf16(r[0], r[1]); o.y = pg8::cvt_pk_bf16(r[2], r[3]);
        *(u32x2*)(O + off) = o; }
};
struct EpiF32B {
    float* C; int ldc; const float* bias;
    __device__ __forceinline__ void operator()(int row, int col, const f32x4& s0, const f32x4& s1) const {
        *(f32x4*)(C + (size_t)row * ldc + col) = s0 + s1 + *(const f32x4*)(bias + col); }
};
template <class Epi>
__device__ __forceinline__ void small_gemm(LAS unsigned char* lds, const bf16_t* A0, const bf16_t* B0, const bf16_t* A1, const bf16_t* B1,
                                           const int lda, const int ldb, const int K, const int parts, const int row0, const int col0, const Epi& E) {
    const int tid = threadIdx.x, w = __builtin_amdgcn_readfirstlane(tid >> 6), lane = tid & 63, fr = lane & 15, fq = lane >> 4;
    const int part = parts == 2 ? (w >> 2) : 0, kw = parts == 2 ? (w & 3) : w, klen = parts == 2 ? K / 4 : K / 8;
    const bf16_t* Ap = (part ? A1 : A0) + (size_t)(row0 + fr) * lda + kw * klen + 8 * fq;
    const bf16_t* Bp = (part ? B1 : B0) + (size_t)(col0 + fr) * ldb + kw * klen + 8 * fq;
    const int nsteps = klen / 32;
    f32x4 acc[4][4];
#pragma unroll
    for (int m = 0; m < 4; ++m)
#pragma unroll
        for (int n = 0; n < 4; ++n) acc[m][n] = (f32x4){0.f, 0.f, 0.f, 0.f};
    bf16x8 a0[4], b0[4], a1[4], b1[4];
#define SG_LD(av, bv, s) do { _Pragma("unroll") for (int m = 0; m < 4; ++m) { av[m] = *(const bf16x8*)(Ap + (size_t)(16 * m) * lda + 32 * (s)); bv[m] = *(const bf16x8*)(Bp + (size_t)(16 * m) * ldb + 32 * (s)); } } while (0)
#define SG_MM(av, bv) do { _Pragma("unroll") for (int m = 0; m < 4; ++m) _Pragma("unroll") for (int n = 0; n < 4; ++n) acc[m][n] = __builtin_amdgcn_mfma_f32_16x16x32_bf16(bv[n], av[m], acc[m][n], 0, 0, 0); } while (0)
    SG_LD(a0, b0, 0);
    for (int s = 0; s < nsteps; s += 2) {
        SG_LD(a1, b1, s + 1);
        SG_MM(a0, b0);
        if (s + 2 < nsteps) SG_LD(a0, b0, s + 2);
        SG_MM(a1, b1);
    }
#undef SG_LD
#undef SG_MM
#pragma unroll
    for (int m = 0; m < 4; ++m)
#pragma unroll
        for (int n = 0; n < 4; ++n) *(LAS f32x4*)(lds + (size_t)(((w * 16 + m * 4 + n) * 64 + lane) * 16)) = acc[m][n];
    __syncthreads();
#pragma unroll
    for (int q = 0; q < 2; ++q) {
        const int p = w + 8 * q; f32x4 s0 = {0.f, 0.f, 0.f, 0.f}, s1 = {0.f, 0.f, 0.f, 0.f};
#pragma unroll
        for (int ww = 0; ww < 4; ++ww) { s0 += *(const LAS f32x4*)(lds + (size_t)(((ww * 16 + p) * 64 + lane) * 16)); s1 += *(const LAS f32x4*)(lds + (size_t)((((ww + 4) * 16 + p) * 64 + lane) * 16)); }
        const int m = p >> 2, n = p & 3;
        E(row0 + 16 * m + fr, col0 + 16 * n + 4 * fq, s0, s1);
    }
    __syncthreads();
}
}

constexpr int NWAVES = 8;
#ifndef MK_N_LAUNCHES
#define MK_N_LAUNCHES 1
#endif
constexpr int NPHASES = 12;
constexpr int N_LAUNCHES = MK_N_LAUNCHES;
constexpr bool K_SP2 = true, K_ALIGN = true;

constexpr int CW_BAR = 4096;
constexpr int RING_OFF = 0, RING_BYTES = 131072;
constexpr int LDSCTL_OFF = RING_BYTES, MISC_OFF = LDSCTL_OFF + 320;
constexpr int LDS_BYTES = 147456;

typedef GAS unsigned gu32;
#define RLX_AGENT __ATOMIC_RELAXED, __HIP_MEMORY_SCOPE_AGENT
#define LDS_WAIT() asm volatile("s_waitcnt lgkmcnt(0)" ::: "memory")
#define VM_WAIT() asm volatile("s_waitcnt vmcnt(0)" ::: "memory")
__device__ __forceinline__ unsigned f2bf(float f) { unsigned u = __builtin_bit_cast(unsigned, f); return (u + 0x7fffu + ((u >> 16) & 1u)) >> 16; }
__device__ __forceinline__ unsigned pk2(float lo, float hi) { return f2bf(lo) | (f2bf(hi) << 16); }
using pg8::bf_lo; using pg8::bf_hi;

#define XB_TMO      128
#define XB_XCNT(j)  (256  + 64 * (j))
#define XB_XSUB(j)  (1280 + 64 * (j))
#define XB_XGEN(j)  (2304 + 64 * (j))
#define XB_TOP      3328
#define XB_TOPGEN   3392
#define XCD_BAR_WORDS 3456
#define XB_SPIN_CAP (1u << 22)
__device__ __forceinline__ unsigned xb_ld(unsigned* p)              { return __hip_atomic_load(p, __ATOMIC_RELAXED, __HIP_MEMORY_SCOPE_AGENT); }
__device__ __forceinline__ unsigned xb_add(unsigned* p, unsigned v) { return __hip_atomic_fetch_add(p, v, __ATOMIC_RELAXED, __HIP_MEMORY_SCOPE_AGENT); }
__device__ __forceinline__ unsigned xb_xcc_id() { return (unsigned)__builtin_amdgcn_s_getreg((3 << 11) | 20) & 0xFu; }
#define XB_SPIN(cond, bar) do { unsigned _sp = 0; while (cond) { __builtin_amdgcn_s_sleep(1); \
    if ((++_sp & 255u) == 0u) { if (xb_ld(&(bar)[XB_TMO])) break; if (_sp > XB_SPIN_CAP) { atomicAdd(&(bar)[XB_TMO], 1u); break; } } } } while (0)
struct XcdBarrier { unsigned* bar; unsigned x; volatile LAS unsigned* st; };
__device__ __forceinline__ XcdBarrier xcd_barrier_post(unsigned* bar, volatile LAS unsigned* st) {
    XcdBarrier b; b.bar = bar; b.x = xb_xcc_id(); b.st = st;
    if (threadIdx.x == 0) (void)xb_add(&bar[XB_XCNT(b.x)], 1u);
    return b;
}
__device__ __forceinline__ void xcd_barrier_complete(unsigned* bar, unsigned x, unsigned& nloc, unsigned& nx) {
    const unsigned G = gridDim.x * gridDim.y * gridDim.z;
    unsigned sum, cnt, mine, sp = 0u;
    for (;;) {
        sum = 0u; cnt = 0u; mine = 0u;
#pragma unroll
        for (unsigned j = 0; j < 16; ++j) { const unsigned c = xb_ld(&bar[XB_XCNT(j)]); sum += c; cnt += (c > 0u) ? 1u : 0u; mine = (j == x) ? c : mine; }
        if (sum == G) break;
        __builtin_amdgcn_s_sleep(1);
        if ((++sp & 255u) == 0u) { if (xb_ld(&bar[XB_TMO])) break; if (sp > XB_SPIN_CAP) { atomicAdd(&bar[XB_TMO], 1u); break; } }
    }
    nloc = mine > 0u ? mine : 1u; nx = cnt > 0u ? cnt : 1u;
}
__device__ __forceinline__ void xcd_barrier(const XcdBarrier& b) {
    asm volatile("s_waitcnt vmcnt(0)" ::: "memory");
    __syncthreads();
    if (threadIdx.x == 0) {
        unsigned* bar = b.bar;
        __builtin_amdgcn_s_waitcnt(0);
        unsigned nloc = b.st[0], nx = b.st[1];
        if (nloc == 0u) { xcd_barrier_complete(bar, b.x, nloc, nx); b.st[0] = nloc; b.st[1] = nx; }
        const unsigned old = xb_add(&bar[XB_XSUB(b.x)], 1u);
        const unsigned gen = old / nloc;
        if (old + 1u == (gen + 1u) * nloc) {
            __builtin_amdgcn_fence(__ATOMIC_RELEASE, "agent");
            asm volatile("s_waitcnt vmcnt(0)" ::: "memory");
            const unsigned og = xb_add(&bar[XB_TOP], 1u);
            const unsigned tg = og / nx;
            if (og + 1u == (tg + 1u) * nx) xb_add(&bar[XB_TOPGEN], 1u);
            else XB_SPIN(xb_ld(&bar[XB_TOPGEN]) == tg, bar);
            __builtin_amdgcn_fence(__ATOMIC_ACQUIRE, "agent");
            xb_add(&bar[XB_XGEN(b.x)], 1u);
            asm volatile("s_waitcnt vmcnt(0)" ::: "memory");
        } else {
            XB_SPIN(xb_ld(&bar[XB_XGEN(b.x)]) == gen, bar);
            __builtin_amdgcn_fence(__ATOMIC_ACQUIRE, "agent");
            asm volatile("s_waitcnt vmcnt(0)" ::: "memory");
        }
    }
    __syncthreads();
}

struct Args { const float* in[23]; float* out; unsigned char* ws; int ph_lo, ph_hi, li, pad; };
struct Frame {
    LAS unsigned char* lds;
    int tid, lane, wave, vcu, G;
    const float* const* in;
    float* out; unsigned char* ws;
};
__device__ __forceinline__ float wave_sum(float v) {
#pragma unroll
    for (int o = 1; o < 64; o <<= 1) v += __shfl_xor(v, o);
    return v;
}
__device__ __forceinline__ float sigm(float x) { return 1.0f / (1.0f + __expf(-x)); }
__device__ __forceinline__ float gelu_tanh(float x) { const float z = 1.5957691216f * (x + 0.044715f * x * x * x); return x / (1.0f + __expf(-z)); }

__device__ __forceinline__ void p0_transpose_item(const float* W, int K, int N, bf16_t* WT, int k0, int n0, int drow0, LAS float* scr, int lane) {
#pragma unroll 8
    for (int i = 0; i < 32; ++i) { const int kk = 2 * i + (lane >> 5); scr[kk * 33 + (lane & 31)] = W[(size_t)(k0 + kk) * N + n0 + (lane & 31)]; }
    LDS_WAIT(); asm volatile("" ::: "memory");
    const int c = lane & 7;
#pragma unroll
    for (int j = 0; j < 4; ++j) { const int n = (lane >> 3) + 8 * j; const LAS float* s = scr + (8 * c) * 33 + n;
        u32x4 o; o.x = pk2(s[0 * 33], s[1 * 33]); o.y = pk2(s[2 * 33], s[3 * 33]); o.z = pk2(s[4 * 33], s[5 * 33]); o.w = pk2(s[6 * 33], s[7 * 33]);
        *(GAS u32x4*)(WT + (size_t)(drow0 + n) * K + k0 + 8 * c) = o; }
    LDS_WAIT(); asm volatile("" ::: "memory");
}
__device__ __forceinline__ int win_drow(int n0) {
    const int seg = n0 >> 11, off = n0 & 2047;
    if (seg == 3) return 6144 + (off >> 7) * 256 + (off & 127);
    if (seg == 4) return 6144 + (off >> 7) * 256 + 128 + (off & 127);
    return n0;
}
__device__ __forceinline__ int wup_drow(int n0) {
    const int seg = n0 >= DFF ? 1 : 0, off = n0 - seg * DFF;
    return (off >> 7) * 256 + seg * 128 + (off & 127);
}
__device__ __forceinline__ void p0_prologue(Frame& F) {
    LAS float* scr = (LAS float*)(F.lds + RING_OFF + F.wave * 16384);
    const int gw = F.vcu * NWAVES + F.wave, NGW = F.G * NWAVES;
    const float* w_ada = F.in[6]; const float* w_in = F.in[10]; const float* w_out_a = F.in[15]; const float* w_out_b = F.in[16]; const float* w_o = F.in[17];
    const float* w_up = F.in[20]; const float* w_down = F.in[22];
    bf16_t* WinT = (bf16_t*)(F.ws + WS_WIN); bf16_t* WadaT = (bf16_t*)(F.ws + WS_WADA); bf16_t* WbT = (bf16_t*)(F.ws + WS_WB); bf16_t* WaT = (bf16_t*)(F.ws + WS_WA);
    bf16_t* WoT = (bf16_t*)(F.ws + WS_WO); bf16_t* WupT = (bf16_t*)(F.ws + WS_WUP); bf16_t* WdT = (bf16_t*)(F.ws + WS_WD);
    constexpr int I_ADA = (DM / 64) * (NMODC / 32), I_IN = (DM / 64) * (INW / 32), I_SQ = (DM / 64) * (DM / 32), I_UP = (DM / 64) * (2 * DFF / 32), I_DN = (DFF / 64) * (DM / 32);
    constexpr int NITEMS = I_ADA + I_IN + 3 * I_SQ + I_UP + I_DN;
    for (int it = gw; it < NITEMS; it += NGW) {
        int r = it;
        if (r < I_ADA) { const int nblk = NMODC / 32, kb = r / nblk, nb = r % nblk; p0_transpose_item(w_ada, DM, NMODC, WadaT, kb * 64, nb * 32, nb * 32, scr, F.lane); continue; } r -= I_ADA;
        if (r < I_IN) { const int nblk = INW / 32, kb = r / nblk, nb = r % nblk; p0_transpose_item(w_in, DM, INW, WinT, kb * 64, nb * 32, win_drow(nb * 32), scr, F.lane); continue; } r -= I_IN;
        if (r < I_SQ) { const int nblk = DM / 32, kb = r / nblk, nb = r % nblk; p0_transpose_item(w_out_b, DM, DM, WbT, kb * 64, nb * 32, nb * 32, scr, F.lane); continue; } r -= I_SQ;
        if (r < I_SQ) { const int nblk = DM / 32, kb = r / nblk, nb = r % nblk; p0_transpose_item(w_out_a, DM, DM, WaT, kb * 64, nb * 32, nb * 32, scr, F.lane); continue; } r -= I_SQ;
        if (r < I_SQ) { const int nblk = DM / 32, kb = r / nblk, nb = r % nblk; p0_transpose_item(w_o, DM, DM, WoT, kb * 64, nb * 32, nb * 32, scr, F.lane); continue; } r -= I_SQ;
        if (r < I_UP) { const int nblk = 2 * DFF / 32, kb = r / nblk, nb = r % nblk; p0_transpose_item(w_up, DM, 2 * DFF, WupT, kb * 64, nb * 32, wup_drow(nb * 32), scr, F.lane); continue; } r -= I_UP;
        { const int nblk = DM / 32, kb = r / nblk, nb = r % nblk; p0_transpose_item(w_down, DFF, DM, WdT, kb * 64, nb * 32, nb * 32, scr, F.lane); }
    }
    bf16_t* S = (bf16_t*)(F.ws + WS_S);
    const float* c_p = F.in[2]; const float* c_s = F.in[3];
    for (int r = gw; r < 256; r += NGW) {
        const float* src = r < NB ? c_p + (size_t)r * DM : c_s + (size_t)(r - NB) * DM;
#pragma unroll
        for (int j = 0; j < 8; ++j) { const int c = 4 * F.lane + 256 * j; u32x2 o = {0u, 0u};
            if (r < NBIDX) { const f32x4 v = *(const f32x4*)(src + c); o.x = pk2(v[0] * sigm(v[0]), v[1] * sigm(v[1])); o.y = pk2(v[2] * sigm(v[2]), v[3] * sigm(v[3])); }
            *(u32x2*)(S + (size_t)r * DM + c) = o; }
    }
}

__device__ __forceinline__ void p_h1(Frame& F) {
    const int gw = F.vcu * NWAVES + F.wave, NGW = F.G * NWAVES;
    const float* g_pre = F.in[8]; const float* MOD = (const float*)(F.ws + WS_MOD); bf16_t* H1 = (bf16_t*)(F.ws + WS_H1);
    for (int r = gw; r < M; r += NGW) {
        const float* xrow = r < MP ? F.in[0] + (size_t)r * DM : F.in[1] + (size_t)(r - MP) * DM;
        const int bidx = r < MP ? r / SEQ : NB + (r - MP) / DS;
        const float* mod = MOD + (size_t)bidx * NMODC;
        f32x4 v[8]; float s = 0.f;
#pragma unroll
        for (int j = 0; j < 8; ++j) { v[j] = *(const f32x4*)(xrow + 4 * F.lane + 256 * j); s += (v[j][0] * v[j][0] + v[j][1] * v[j][1]) + (v[j][2] * v[j][2] + v[j][3] * v[j][3]); }
        const float rstd = 1.0f / sqrtf(wave_sum(s) * (1.0f / DM) + EPS);
#pragma unroll
        for (int j = 0; j < 8; ++j) { const int c = 4 * F.lane + 256 * j;
            const f32x4 g = *(const f32x4*)(g_pre + c), sh = *(const f32x4*)(mod + c), sc = *(const f32x4*)(mod + DM + c);
            const f32x4 h = v[j] * rstd * g * (sc + 1.0f) + sh;
            u32x2 o; o.x = pk2(h[0], h[1]); o.y = pk2(h[2], h[3]);
            *(u32x2*)(H1 + (size_t)r * DM + c) = o; }
    }
}

template <int ACT>
__device__ __forceinline__ void conv_gate(Frame& F, const bf16_t* A, const bf16_t* B, bf16_t* O, const int C, const float* w, const float* state, float* out_p, float* out_s) {
    const int C8 = C / 8, NRB = M / 16, total = NRB * C8;
    const int gtid = F.vcu * (NWAVES * 64) + F.tid, NT = F.G * NWAVES * 64;
    for (int idx = gtid; idx < total; idx += NT) {
        const int c8 = idx % C8, rb = idx / C8, c = c8 * 8, r0 = rb * 16;
        float w0[8], w1[8], w2[8];
#pragma unroll
        for (int h = 0; h < 2; ++h) { const f32x4 a = *(const f32x4*)(w + c + 4 * h), b = *(const f32x4*)(w + C + c + 4 * h), d = *(const f32x4*)(w + 2 * C + c + 4 * h);
#pragma unroll
            for (int i = 0; i < 4; ++i) { w0[4 * h + i] = a[i]; w1[4 * h + i] = b[i]; w2[4 * h + i] = d[i]; } }
        float p2[8], p1[8];
        const bool prompt = r0 < MP;
        const int t0 = prompt ? (r0 % SEQ) : 0, bb = prompt ? (r0 / SEQ) : 0;
        if (prompt) {
            if (t0 == 0) {
#pragma unroll
                for (int i = 0; i < 8; ++i) { p2[i] = 0.f; p1[i] = 0.f; }
            } else {
                const u32x4 q2 = *(const u32x4*)(A + (size_t)(r0 - 2) * C + c), q1 = *(const u32x4*)(A + (size_t)(r0 - 1) * C + c);
                p2[0] = bf_lo(q2.x); p2[1] = bf_hi(q2.x); p2[2] = bf_lo(q2.y); p2[3] = bf_hi(q2.y); p2[4] = bf_lo(q2.z); p2[5] = bf_hi(q2.z); p2[6] = bf_lo(q2.w); p2[7] = bf_hi(q2.w);
                p1[0] = bf_lo(q1.x); p1[1] = bf_hi(q1.x); p1[2] = bf_lo(q1.y); p1[3] = bf_hi(q1.y); p1[4] = bf_lo(q1.z); p1[5] = bf_hi(q1.z); p1[6] = bf_lo(q1.w); p1[7] = bf_hi(q1.w);
            }
        }
#pragma unroll 4
        for (int i = 0; i < 16; ++i) {
            const int r = r0 + i;
            if (!prompt && (i & 3) == 0) {
                const int sb = (r - MP) >> 2;
#pragma unroll
                for (int h = 0; h < 2; ++h) { const f32x4 s2 = *(const f32x4*)(state + ((size_t)sb * 2 + 0) * C + c + 4 * h), s1 = *(const f32x4*)(state + ((size_t)sb * 2 + 1) * C + c + 4 * h);
#pragma unroll
                    for (int k = 0; k < 4; ++k) { p2[4 * h + k] = s2[k]; p1[4 * h + k] = s1[k]; } }
            }
            const u32x4 qa = *(const u32x4*)(A + (size_t)r * C + c), qb = *(const u32x4*)(B + (size_t)r * C + c);
            float a[8], b[8], o[8];
            a[0] = bf_lo(qa.x); a[1] = bf_hi(qa.x); a[2] = bf_lo(qa.y); a[3] = bf_hi(qa.y); a[4] = bf_lo(qa.z); a[5] = bf_hi(qa.z); a[6] = bf_lo(qa.w); a[7] = bf_hi(qa.w);
            b[0] = bf_lo(qb.x); b[1] = bf_hi(qb.x); b[2] = bf_lo(qb.y); b[3] = bf_hi(qb.y); b[4] = bf_lo(qb.z); b[5] = bf_hi(qb.z); b[6] = bf_lo(qb.w); b[7] = bf_hi(qb.w);
#pragma unroll
            for (int k = 0; k < 8; ++k) { const float y = w0[k] * p2[k] + w1[k] * p1[k] + w2[k] * a[k]; o[k] = (ACT == 1 ? gelu_tanh(y) : y) * b[k]; p2[k] = p1[k]; p1[k] = a[k]; }
            u32x4 ov; ov.x = pk2(o[0], o[1]); ov.y = pk2(o[2], o[3]); ov.z = pk2(o[4], o[5]); ov.w = pk2(o[6], o[7]);
            *(u32x4*)(O + (size_t)r * C + c) = ov;
            float* so = nullptr;
            if (prompt) { const int t = t0 + i; if (t >= SEQ - 2) so = out_p + ((size_t)bb * 2 + (t - (SEQ - 2))) * C + c; }
            else { const int tt = i & 3; if (tt >= 2) so = out_s + ((size_t)((r - MP) >> 2) * 2 + (tt - 2)) * C + c; }
            if (so) { *(f32x4*)so = (f32x4){a[0], a[1], a[2], a[3]}; *(f32x4*)(so + 4) = (f32x4){a[4], a[5], a[6], a[7]}; }
        }
    }
}

__device__ __forceinline__ void p_gate(Frame& F) {
    const bf16_t* U = (const bf16_t*)(F.ws + WS_U); const bf16_t* V = (const bf16_t*)(F.ws + WS_V); const bf16_t* BG = (const bf16_t*)(F.ws + WS_BG); const bf16_t* P = (const bf16_t*)(F.ws + WS_P);
    bf16_t* YA = (bf16_t*)(F.ws + WS_YA); bf16_t* YB = (bf16_t*)(F.ws + WS_YB); const float* VSS = (const float*)(F.ws + WS_VSS);
    const float* g_v = F.in[11]; const float* w_s = F.in[12]; const float* b_s = F.in[13];
    LAS float* rs = (LAS float*)(F.lds);
    LAS bf16_t* VT = (LAS bf16_t*)(F.lds + 1024);
    constexpr int VTS = 136;
    const int tid = F.tid, lane = F.lane, w = F.wave;
    for (int it = F.vcu; it < (MP / 128) * 16; it += F.G) {
        const int ch = it >> 4, g = it & 15, r0 = ch * 128;
        if (tid < 128) { const f32x4* p = (const f32x4*)(VSS + (size_t)(r0 + tid) * 32); float s = 0.f;
#pragma unroll
            for (int q = 0; q < 8; ++q) { const f32x4 a = p[q]; s += (a[0] + a[1]) + (a[2] + a[3]); }
            rs[tid] = 1.0f / sqrtf(s * (1.0f / DM) + EPS); }
        __syncthreads();
        { const int s_ = tid >> 2, cq = (tid & 3) * 32; const float rsd = rs[s_];
#pragma unroll
          for (int q = 0; q < 4; ++q) { const int c = cq + 8 * q;
              const u32x4 raw = *(const u32x4*)(V + (size_t)(r0 + s_) * DM + g * 128 + c);
              const f32x4 g0 = *(const f32x4*)(g_v + g * 128 + c), g1 = *(const f32x4*)(g_v + g * 128 + c + 4);
              float x[8] = {bf_lo(raw.x), bf_hi(raw.x), bf_lo(raw.y), bf_hi(raw.y), bf_lo(raw.z), bf_hi(raw.z), bf_lo(raw.w), bf_hi(raw.w)};
#pragma unroll
              for (int j = 0; j < 8; ++j) { const float gg = j < 4 ? g0[j & 3] : g1[j & 3]; VT[(c + j) * VTS + s_] = (bf16_t)f2bf(x[j] * rsd * gg); } } }
        __syncthreads();
        f32x4 acc[8];
#pragma unroll
        for (int cb = 0; cb < 8; ++cb) acc[cb] = (f32x4){0.f, 0.f, 0.f, 0.f};
        const int t = 16 * w + (lane & 15);
        for (int kk = 0; kk <= (w >> 1); ++kk) {
            const int s0 = 32 * kk + 8 * (lane >> 4);
            const float* wp = w_s + ((size_t)g * 128 + t) * 128 + s0;
            const f32x4 wa = *(const f32x4*)wp, wb = *(const f32x4*)(wp + 4);
            float wv[8] = {wa[0], wa[1], wa[2], wa[3], wb[0], wb[1], wb[2], wb[3]};
#pragma unroll
            for (int j = 0; j < 8; ++j) if (s0 + j > t) wv[j] = 0.f;
            u32x4 bw; bw.x = pk2(wv[0], wv[1]); bw.y = pk2(wv[2], wv[3]); bw.z = pk2(wv[4], wv[5]); bw.w = pk2(wv[6], wv[7]);
            const bf16x8 bfrag = __builtin_bit_cast(bf16x8, bw);
#pragma unroll
            for (int cb = 0; cb < 8; ++cb) {
                const bf16x8 afrag = *(const LAS bf16x8*)(VT + (16 * cb + (lane & 15)) * VTS + s0);
                acc[cb] = __builtin_amdgcn_mfma_f32_16x16x32_bf16(afrag, bfrag, acc[cb], 0, 0, 0);
            }
        }
        { const int row = r0 + t; const float bsv = b_s[g * 128 + t];
#pragma unroll
          for (int cb = 0; cb < 8; ++cb) { const int col = g * 128 + 16 * cb + 4 * (lane >> 4);
              const u32x2 uu = *(const u32x2*)(U + (size_t)row * DM + col);
              u32x2 o; o.x = pk2(bf_lo(uu.x) * (acc[cb][0] + bsv), bf_hi(uu.x) * (acc[cb][1] + bsv)); o.y = pk2(bf_lo(uu.y) * (acc[cb][2] + bsv), bf_hi(uu.y) * (acc[cb][3] + bsv));
              *(u32x2*)(YA + (size_t)row * DM + col) = o; } }
        __syncthreads();
    }
    conv_gate<0>(F, P, BG, YB, DM, F.in[14], F.in[4], F.out + O_CBP, F.out + O_CBS);
    for (int it = F.vcu; it < DB / 2; it += F.G) {
        const int sb = it * 2 + (tid >> 8), c = (tid & 255) * 8, rb = MP + sb * 4, g = c >> 7;
        if (tid < 8) { const int row = MP + it * 8 + tid; const f32x4* p = (const f32x4*)(VSS + (size_t)row * 32); float s = 0.f;
#pragma unroll
            for (int q = 0; q < 8; ++q) { const f32x4 a = p[q]; s += (a[0] + a[1]) + (a[2] + a[3]); }
            rs[tid] = 1.0f / sqrtf(s * (1.0f / DM) + EPS); }
        __syncthreads();
        float vn[4][8];
        const f32x4 g0 = *(const f32x4*)(g_v + c), g1 = *(const f32x4*)(g_v + c + 4);
#pragma unroll
        for (int tt = 0; tt < 4; ++tt) { const float rsd = rs[(tid >> 8) * 4 + tt];
            const u32x4 raw = *(const u32x4*)(V + (size_t)(rb + tt) * DM + c);
            float x[8] = {bf_lo(raw.x), bf_hi(raw.x), bf_lo(raw.y), bf_hi(raw.y), bf_lo(raw.z), bf_hi(raw.z), bf_lo(raw.w), bf_hi(raw.w)};
#pragma unroll
            for (int j = 0; j < 8; ++j) vn[tt][j] = x[j] * rsd * (j < 4 ? g0[j & 3] : g1[j & 3]);
            float* cv = F.out + O_CV + ((size_t)sb * 4 + tt) * DM + c;
            *(f32x4*)cv = (f32x4){vn[tt][0], vn[tt][1], vn[tt][2], vn[tt][3]}; *(f32x4*)(cv + 4) = (f32x4){vn[tt][4], vn[tt][5], vn[tt][6], vn[tt][7]}; }
#pragma unroll
        for (int tt = 0; tt < 4; ++tt) {
            float sacc[8]; const float bsv = b_s[g * 128 + tt];
#pragma unroll
            for (int j = 0; j < 8; ++j) sacc[j] = bsv;
#pragma unroll
            for (int ss = 0; ss < 4; ++ss) if (ss <= tt) { const float ww = w_s[((size_t)g * 128 + tt) * 128 + ss];
#pragma unroll
                for (int j = 0; j < 8; ++j) sacc[j] += ww * vn[ss][j]; }
            const u32x4 uu = *(const u32x4*)(U + (size_t)(rb + tt) * DM + c);
            u32x4 o; o.x = pk2(bf_lo(uu.x) * sacc[0], bf_hi(uu.x) * sacc[1]); o.y = pk2(bf_lo(uu.y) * sacc[2], bf_hi(uu.y) * sacc[3]);
            o.z = pk2(bf_lo(uu.z) * sacc[4], bf_hi(uu.z) * sacc[5]); o.w = pk2(bf_lo(uu.w) * sacc[6], bf_hi(uu.w) * sacc[7]);
            *(u32x4*)(YA + (size_t)(rb + tt) * DM + c) = o; }
        __syncthreads();
    }
}

__device__ __forceinline__ void p_x1h2(Frame& F) {
    const int gw = F.vcu * NWAVES + F.wave, NGW = F.G * NWAVES;
    const bf16_t* T = (const bf16_t*)(F.ws + WS_T); bf16_t* H2 = (bf16_t*)(F.ws + WS_H2); const float* MOD = (const float*)(F.ws + WS_MOD);
    const float* g_post = F.in[9]; const float* g_pre2 = F.in[18];
    for (int r = gw; r < M; r += NGW) {
        const float* xrow = r < MP ? F.in[0] + (size_t)r * DM : F.in[1] + (size_t)(r - MP) * DM;
        const int bidx = r < MP ? r / SEQ : NB + (r - MP) / DS;
        const float* mod = MOD + (size_t)bidx * NMODC;
        float tv[4][8]; float s = 0.f;
#pragma unroll
        for (int j = 0; j < 4; ++j) { const u32x4 raw = *(const u32x4*)(T + (size_t)r * DM + 8 * F.lane + 512 * j);
            tv[j][0] = bf_lo(raw.x); tv[j][1] = bf_hi(raw.x); tv[j][2] = bf_lo(raw.y); tv[j][3] = bf_hi(raw.y); tv[j][4] = bf_lo(raw.z); tv[j][5] = bf_hi(raw.z); tv[j][6] = bf_lo(raw.w); tv[j][7] = bf_hi(raw.w);
#pragma unroll
            for (int k = 0; k < 8; ++k) s += tv[j][k] * tv[j][k]; }
        const float rstdT = 1.0f / sqrtf(wave_sum(s) * (1.0f / DM) + EPS);
        float s1 = 0.f;
#pragma unroll
        for (int j = 0; j < 4; ++j) { const int c = 8 * F.lane + 512 * j;
#pragma unroll
            for (int h = 0; h < 2; ++h) { const f32x4 xv = *(const f32x4*)(xrow + c + 4 * h), gp = *(const f32x4*)(g_post + c + 4 * h), gt = *(const f32x4*)(mod + 2 * DM + c + 4 * h);
                f32x4 x1;
#pragma unroll
                for (int k = 0; k < 4; ++k) { x1[k] = xv[k] + gt[k] * (tv[j][4 * h + k] * rstdT * gp[k]); tv[j][4 * h + k] = x1[k]; s1 += x1[k] * x1[k]; }
                *(f32x4*)(F.out + O_Y + (size_t)r * DM + c + 4 * h) = x1; } }
        const float rstd1 = 1.0f / sqrtf(wave_sum(s1) * (1.0f / DM) + EPS);
#pragma unroll
        for (int j = 0; j < 4; ++j) { const int c = 8 * F.lane + 512 * j; float h2[8];
#pragma unroll
            for (int h = 0; h < 2; ++h) { const f32x4 gp = *(const f32x4*)(g_pre2 + c + 4 * h), sh = *(const f32x4*)(mod + 3 * DM + c + 4 * h), sc = *(const f32x4*)(mod + 4 * DM + c + 4 * h);
#pragma unroll
                for (int k = 0; k < 4; ++k) h2[4 * h + k] = tv[j][4 * h + k] * rstd1 * gp[k] * (1.0f + sc[k]) + sh[k]; }
            u32x4 o; o.x = pk2(h2[0], h2[1]); o.y = pk2(h2[2], h2[3]); o.z = pk2(h2[4], h2[5]); o.w = pk2(h2[6], h2[7]);
            *(u32x4*)(H2 + (size_t)r * DM + c) = o; }
    }
}


__device__ __forceinline__ void p_ffn_fix(Frame& F) {
    const float* SA = (const float*)(F.ws + WS_SA); const float* SB = (const float*)(F.ws + WS_SB); const float* SAS = (const float*)(F.ws + WS_SAS); const float* SBS = (const float*)(F.ws + WS_SBS);
    bf16_t* G = (bf16_t*)(F.ws + WS_G); const float* cw = F.in[21]; const float* state = F.in[5];
    constexpr int C4 = DFF / 4;
    const int gtid = F.vcu * (NWAVES * 64) + F.tid, NT = F.G * NWAVES * 64;
    const f32x4 z4 = {0.f, 0.f, 0.f, 0.f};
    for (int idx = gtid; idx < 256 * C4; idx += NT) {
        const int c = (idx % C4) * 4, ri = idx / C4, rb64 = ri >> 1, which = ri & 1, r = 64 * rb64 + which; const bool ss = (rb64 & 31) == 0;
        const f32x4 a = *(const f32x4*)(SA + (size_t)(rb64 * 4 + 2 + which) * DFF + c), b = *(const f32x4*)(SB + (size_t)(rb64 * 2 + which) * DFF + c);
        f32x4 p1, p2;
        if (which == 0) { p1 = ss ? z4 : *(const f32x4*)(SA + (size_t)((rb64 - 1) * 4 + 1) * DFF + c); p2 = ss ? z4 : *(const f32x4*)(SA + (size_t)((rb64 - 1) * 4 + 0) * DFF + c); }
        else { p1 = *(const f32x4*)(SA + (size_t)(rb64 * 4 + 2) * DFF + c); p2 = ss ? z4 : *(const f32x4*)(SA + (size_t)((rb64 - 1) * 4 + 1) * DFF + c); }
        const f32x4 w0 = *(const f32x4*)(cw + c), w1 = *(const f32x4*)(cw + DFF + c), w2 = *(const f32x4*)(cw + 2 * DFF + c);
        float o[4];
#pragma unroll
        for (int i = 0; i < 4; ++i) o[i] = pg8::gelu_fast(w0[i] * p2[i] + w1[i] * p1[i] + w2[i] * a[i]) * b[i];
        u32x2 ov; ov.x = pk2(o[0], o[1]); ov.y = pk2(o[2], o[3]);
        *(u32x2*)(G + (size_t)r * DFF + c) = ov;
    }
    for (int idx = gtid; idx < NB * 2 * C4; idx += NT) {
        const int c = (idx % C4) * 4, ri = idx / C4, bb = ri >> 1, k = ri & 1;
        *(f32x4*)(F.out + O_CFP + (size_t)ri * DFF + c) = *(const f32x4*)(SA + (size_t)((bb * 32 + 31) * 4 + k) * DFF + c);
    }
    for (int idx = gtid; idx < DB * C4; idx += NT) {
        const int c = (idx % C4) * 4, sb = idx / C4;
        const f32x4 w0 = *(const f32x4*)(cw + c), w1 = *(const f32x4*)(cw + DFF + c), w2 = *(const f32x4*)(cw + 2 * DFF + c);
        f32x4 p2 = *(const f32x4*)(state + ((size_t)sb * 2 + 0) * DFF + c), p1 = *(const f32x4*)(state + ((size_t)sb * 2 + 1) * DFF + c);
#pragma unroll
        for (int tt = 0; tt < 4; ++tt) {
            const f32x4 a = *(const f32x4*)(SAS + (size_t)(sb * 4 + tt) * DFF + c), b = *(const f32x4*)(SBS + (size_t)(sb * 4 + tt) * DFF + c);
            float o[4];
#pragma unroll
            for (int i = 0; i < 4; ++i) o[i] = pg8::gelu_fast(w0[i] * p2[i] + w1[i] * p1[i] + w2[i] * a[i]) * b[i];
            u32x2 ov; ov.x = pk2(o[0], o[1]); ov.y = pk2(o[2], o[3]);
            *(u32x2*)(G + (size_t)(MP + sb * 4 + tt) * DFF + c) = ov;
            if (tt >= 2) *(f32x4*)(F.out + O_CFS + ((size_t)sb * 2 + (tt - 2)) * DFF + c) = a;
            p2 = p1; p1 = a;
        }
    }
}

__device__ __forceinline__ void p_final(Frame& F) {
    const int gw = F.vcu * NWAVES + F.wave, NGW = F.G * NWAVES;
    const bf16_t* Fb = (const bf16_t*)(F.ws + WS_F); const float* MOD = (const float*)(F.ws + WS_MOD); const float* g_post = F.in[19];
    for (int r = gw; r < M; r += NGW) {
        const int bidx = r < MP ? r / SEQ : NB + (r - MP) / DS;
        const float* mod = MOD + (size_t)bidx * NMODC;
        float tv[4][8]; float s = 0.f;
#pragma unroll
        for (int j = 0; j < 4; ++j) { const u32x4 raw = *(const u32x4*)(Fb + (size_t)r * DM + 8 * F.lane + 512 * j);
            tv[j][0] = bf_lo(raw.x); tv[j][1] = bf_hi(raw.x); tv[j][2] = bf_lo(raw.y); tv[j][3] = bf_hi(raw.y); tv[j][4] = bf_lo(raw.z); tv[j][5] = bf_hi(raw.z); tv[j][6] = bf_lo(raw.w); tv[j][7] = bf_hi(raw.w);
#pragma unroll
            for (int k = 0; k < 8; ++k) s += tv[j][k] * tv[j][k]; }
        const float rstd = 1.0f / sqrtf(wave_sum(s) * (1.0f / DM) + EPS);
#pragma unroll
        for (int j = 0; j < 4; ++j) { const int c = 8 * F.lane + 512 * j;
#pragma unroll
            for (int h = 0; h < 2; ++h) { float* yp = F.out + O_Y + (size_t)r * DM + c + 4 * h;
                const f32x4 xv = *(const f32x4*)yp, gp = *(const f32x4*)(g_post + c + 4 * h), gt = *(const f32x4*)(mod + 5 * DM + c + 4 * h);
                f32x4 y;
#pragma unroll
                for (int k = 0; k < 4; ++k) y[k] = xv[k] + gt[k] * (tv[j][4 * h + k] * rstd * gp[k]);
                *(f32x4*)yp = y; } }
    }
}

__global__ void __launch_bounds__(NWAVES * 64, 2) fwd_megakernel(Args args) {
    extern __shared__ __attribute__((aligned(16))) unsigned char lds[];
    Frame F;
    F.lds = (LAS unsigned char*)lds;
    F.tid = threadIdx.x; F.lane = F.tid & 63; F.wave = __builtin_amdgcn_readfirstlane(F.tid >> 6);
    F.G = gridDim.x; { const int bx = blockIdx.x; F.vcu = (F.G % 8 == 0) ? (bx % 8) * (F.G / 8) + bx / 8 : bx; }
    F.in = args.in; F.out = args.out; F.ws = args.ws;
    unsigned char* ws = args.ws;
    volatile LAS unsigned* MISC = (volatile LAS unsigned*)(F.lds + MISC_OFF);
    for (int u = F.tid; u < (LDS_BYTES - LDSCTL_OFF) / 4; u += NWAVES * 64) ((LAS unsigned*)(F.lds + LDSCTL_OFF))[u] = 0u;
    __syncthreads();
    XcdBarrier bar; bar.bar = (unsigned*)(ws + WS_CTL) + CW_BAR; bar.x = 0; bar.st = nullptr;
    if (N_LAUNCHES == 1) bar = xcd_barrier_post((unsigned*)(ws + WS_CTL) + CW_BAR, MISC + 8);
    const int lo = args.ph_lo, hi = args.ph_hi;
#define IN(k) (lo <= (k) && (k) < hi)
#define SEAM(k) do { if (IN(k) && IN((k) + 1)) xcd_barrier(bar); } while (0)
    using namespace pg8;
    LAS unsigned char* ring = F.lds + RING_OFF;
    const int cid = (int)blockIdx.x;

    if (IN(0)) { p0_prologue(F); } SEAM(0);
    if (IN(1)) {
        sg::EpiF32B E{(float*)(ws + WS_MOD), NMODC, F.in[7]};
        for (int u = F.vcu; u < 3 * (NMODC / 64); u += F.G) { const int pn = u / 3, pmr = u % 3;
            sg::small_gemm(ring, (const bf16_t*)(ws + WS_S), (const bf16_t*)(ws + WS_WADA), nullptr, nullptr, DM, DM, DM, 1, 64 * pmr, 64 * pn, E); }
    } SEAM(1);
    if (IN(2)) { p_h1(F); } SEAM(2);
    if (IN(3)) {
        Ptrs g{(const bf16_t*)(ws + WS_H1), (const bf16_t*)(ws + WS_WIN), nullptr, nullptr, DM, DM};
        StaticOrder S; S.init(M / 256, INW / 256, F.G, cid, 1);
        EpiIn E{(bf16_t*)(ws + WS_U), (bf16_t*)(ws + WS_V), (bf16_t*)(ws + WS_BG), (bf16_t*)(ws + WS_P), (bf16_t*)(ws + WS_SGA), (bf16_t*)(ws + WS_SGB), (float*)(ws + WS_VSS)};
        gemm_phase<EpiIn, StaticOrder, K_ALIGN, K_SP2>(ring, g, DM, S, E);
    } SEAM(3);
    if (IN(4)) { p_gate(F); } SEAM(4);
    if (IN(5)) {
        Ptrs g{(const bf16_t*)(ws + WS_YB), (const bf16_t*)(ws + WS_WB), (const bf16_t*)(ws + WS_YA), (const bf16_t*)(ws + WS_WA), DM, DM};
        StaticOrder S; S.init(MP / 256, DM / 256, F.G, cid, 2);
        EpiOut E{(const bf16_t*)(ws + WS_SGA), (const bf16_t*)(ws + WS_SGB), (bf16_t*)(ws + WS_MERGED)};
        gemm_phase<EpiOut, StaticOrder, K_ALIGN, K_SP2>(ring, g, DM, S, E);
        sg::EpiOutS Es{(const bf16_t*)(ws + WS_SGA), (const bf16_t*)(ws + WS_SGB), (bf16_t*)(ws + WS_MERGED)};
        for (int u = cid; u < (MS / 64) * (DM / 64); u += F.G)
            sg::small_gemm(ring, g.A0, g.B0, g.A1, g.B1, DM, DM, DM, 2, MP + 64 * (u / (DM / 64)), 64 * (u % (DM / 64)), Es);
    } SEAM(5);
    if (IN(6)) {
        Ptrs g{(const bf16_t*)(ws + WS_MERGED), (const bf16_t*)(ws + WS_WO), nullptr, nullptr, DM, DM};
        StaticOrder S; S.init(MP / 256, DM / 256, F.G, cid, 1);
        EpiBf16 E{(bf16_t*)(ws + WS_T), DM};
        gemm_phase<EpiBf16, StaticOrder, K_ALIGN, K_SP2>(ring, g, DM, S, E);
        sg::EpiSum Es{(bf16_t*)(ws + WS_T), DM};
        for (int u = cid; u < (MS / 64) * (DM / 64); u += F.G)
            sg::small_gemm(ring, g.A0, g.B0, nullptr, nullptr, DM, DM, DM, 1, MP + 64 * (u / (DM / 64)), 64 * (u % (DM / 64)), Es);
    } SEAM(6);
    if (IN(7)) { p_x1h2(F); } SEAM(7);
    if (IN(8)) {
        Ptrs g{(const bf16_t*)(ws + WS_H2), (const bf16_t*)(ws + WS_WUP), nullptr, nullptr, DM, DM};
        StaticOrder S; S.init(M / 256, 2 * DFF / 256, F.G, cid, 1);
        EpiUpF E{(bf16_t*)(ws + WS_G), (float*)(ws + WS_SA), (float*)(ws + WS_SB), (float*)(ws + WS_SAS), (float*)(ws + WS_SBS), F.in[21]};
        gemm_phase<EpiUpF, StaticOrder, K_ALIGN, K_SP2>(ring, g, DM, S, E);
    } SEAM(8);
    if (IN(9)) { p_ffn_fix(F); } SEAM(9);
    if (IN(10)) {
        Ptrs g{(const bf16_t*)(ws + WS_G), (const bf16_t*)(ws + WS_WD), nullptr, nullptr, DFF, DFF};
        StaticOrder S; S.init(MP / 256, DM / 256, F.G, cid, 1);
        EpiBf16 E{(bf16_t*)(ws + WS_F), DM};
        gemm_phase<EpiBf16, StaticOrder, K_ALIGN, K_SP2>(ring, g, DFF, S, E);
        sg::EpiSum Es{(bf16_t*)(ws + WS_F), DM};
        for (int u = cid; u < (MS / 64) * (DM / 64); u += F.G)
            sg::small_gemm(ring, g.A0, g.B0, nullptr, nullptr, DFF, DFF, DFF, 1, MP + 64 * (u / (DM / 64)), 64 * (u % (DM / 64)), Es);
    } SEAM(10);
    if (IN(11)) { p_final(F); }
#undef IN
#undef SEAM
}

extern "C" void kernel_launch(void* const* d_in, const int* in_sizes, int n_in, void* d_out, int out_size, void* d_ws, size_t ws_size, hipStream_t stream) {
    static int grid = 0;
    if (grid == 0) {
        if (n_in != 23 || out_size != (int)O_END || ws_size < WS_END) { fprintf(stderr, "kernel_launch: unexpected shapes: n_in %d out %d ws %zu (need %zu)\n", n_in, out_size, ws_size, (size_t)WS_END); grid = -1; return; }
        int dev = 0, cus = 0, per_cu = 0;
        if (hipGetDevice(&dev) != hipSuccess || hipDeviceGetAttribute(&cus, hipDeviceAttributeMultiprocessorCount, dev) != hipSuccess) { grid = -1; return; }
        if (hipFuncSetAttribute((const void*)fwd_megakernel, hipFuncAttributeMaxDynamicSharedMemorySize, LDS_BYTES) != hipSuccess) { fprintf(stderr, "kernel_launch: hipFuncSetAttribute failed\n"); grid = -1; return; }
        if (hipOccupancyMaxActiveBlocksPerMultiprocessor(&per_cu, (const void*)fwd_megakernel, NWAVES * 64, LDS_BYTES) != hipSuccess || per_cu < 1) { fprintf(stderr, "kernel_launch: occupancy query says %d blocks per CU\n", per_cu); (void)hipGetLastError(); grid = -1; return; }
        grid = cus;
    }
    if (grid < 0) return;
    (void)hipMemsetAsync((char*)d_ws + WS_CTL, 0, CTL_ZERO_BYTES, stream);
    Args a{};
    for (int i = 0; i < 23; ++i) a.in[i] = (const float*)d_in[i];
    a.out = (float*)d_out; a.ws = (unsigned char*)d_ws;
    if (N_LAUNCHES == 1) {
        a.ph_lo = 0; a.ph_hi = NPHASES; a.li = 0;
        hipLaunchKernelGGL(fwd_megakernel, dim3(grid), dim3(NWAVES * 64), LDS_BYTES, stream, a);
    } else {
        for (int li = 0; li < NPHASES; ++li) { a.ph_lo = li; a.ph_hi = li + 1; a.li = li;
            hipLaunchKernelGGL(fwd_megakernel, dim3(grid), dim3(NWAVES * 64), LDS_BYTES, stream, a); }
    }
    const hipError_t le = hipPeekAtLastError();
    if (le != hipSuccess) fprintf(stderr, "kernel_launch: launch failed: %s\n", hipGetErrorName(le));
}
```

```cpp
#include <hip/hip_runtime.h>
#include <cstdio>
#include <cstdint>

#define LAS __attribute__((address_space(3)))
#define GAS __attribute__((address_space(1)))
typedef unsigned short bf16_t;
typedef short bf16x8 __attribute__((ext_vector_type(8)));
typedef float f32x4 __attribute__((ext_vector_type(4)));
typedef float f32x2 __attribute__((ext_vector_type(2)));
typedef unsigned u32x4 __attribute__((ext_vector_type(4)));
typedef unsigned u32x2 __attribute__((ext_vector_type(2)));

constexpr int DM = 2048, NB = 4, SEQ = 2048, DB = 128, DS = 4, DFF = 5632, INW = 14336, NMODC = 6 * DM;
constexpr int MP = NB * SEQ, MS = DB * DS, M = MP + MS;
constexpr int NBIDX = NB + DB;
constexpr float EPS = 1e-6f;

constexpr size_t MiB = 1u << 20;
constexpr size_t WS_CTL = 0, CTL_ZERO_BYTES = 1 * MiB;
constexpr size_t WS_S = 1 * MiB;
constexpr size_t WS_MOD = 2 * MiB;
constexpr size_t WS_VSS = 14 * MiB;
constexpr size_t WS_WIN = 16 * MiB;
constexpr size_t WS_WB = 72 * MiB, WS_WA = 80 * MiB, WS_WO = 88 * MiB;
constexpr size_t WS_WUP = 96 * MiB;
constexpr size_t WS_WD = 140 * MiB;
constexpr size_t WS_R1 = 162 * MiB;
constexpr size_t SLOT = 34 * MiB;
constexpr size_t WS_H1 = WS_R1, WS_YA = WS_R1, WS_H2 = WS_R1, WS_YB = WS_R1 + SLOT, WS_WADA = WS_R1;
constexpr size_t WS_R2 = 230 * MiB;
constexpr size_t WS_U = WS_R2, WS_V = WS_R2 + SLOT, WS_BG = WS_R2 + 2 * SLOT, WS_P = WS_R2 + 3 * SLOT, WS_SGA = WS_R2 + 4 * SLOT, WS_SGB = WS_R2 + 5 * SLOT;
constexpr size_t WS_MERGED = WS_R2, WS_T = WS_R2 + SLOT;
constexpr size_t WS_G = WS_R2;
constexpr size_t WS_SA = 324 * MiB;
constexpr size_t WS_SB = 335 * MiB;
constexpr size_t WS_SAS = 341 * MiB, WS_SBS = 352 * MiB;
constexpr size_t WS_F = WS_R1 + SLOT;
constexpr size_t WS_END = 434 * MiB;
static_assert(WS_G + (size_t)M * DFF * 2 <= WS_SA && WS_SA + (size_t)512 * DFF * 4 <= WS_SB && WS_SB + (size_t)256 * DFF * 4 <= WS_SAS && WS_SAS + (size_t)512 * DFF * 4 <= WS_SBS && WS_SBS + (size_t)512 * DFF * 4 <= WS_END, "ws map");
static_assert((size_t)M * DM * 2 == SLOT, "slot size");

constexpr size_t O_Y = 0, O_CBP = (size_t)M * DM, O_CBS = O_CBP + (size_t)NB * 2 * DM, O_CFP = O_CBS + (size_t)DB * 2 * DM,
                 O_CFS = O_CFP + (size_t)NB * 2 * DFF, O_CV = O_CFS + (size_t)DB * 2 * DFF, O_END = O_CV + (size_t)MS * DM;

namespace pg8 {
constexpr int BM = 256, BK = 64, HALF = 128, HTB = HALF * BK * 2, STAGE_BYTES = 8 * HTB, NXCD = 8, WGM = 8;
__host__ __device__ __forceinline__ int lds_byte(int r, int c) { const int st = (r >> 4) * 2 + (c >> 5), rr = r & 15, cc = c & 31, ob = rr * 64 + cc * 2; return st * 1024 + (ob ^ (((ob >> 9) & 1) << 5)); }
__host__ __device__ __forceinline__ void stage_rc(int b, int& R, int& C) { const int st = b / 1024, sb = b % 1024, swz = sb ^ (((sb >> 9) & 1) << 5); R = (st >> 1) * 16 + swz / 64; C = (st & 1) * 32 + (swz % 64) / 2; }
__host__ __device__ __forceinline__ int perm32(int rho) { const int n = rho >> 4, i = rho & 15; return 8 * (i >> 2) + 4 * n + (i & 3); }

struct Unit { int pm, pn, part; };

struct StaticOrder {
    int nM, nN, nwg, G, c, parts;
    __device__ void init(int nM_, int nN_, int G_, int c_, int parts_) { nM = nM_; nN = nN_; nwg = nM * nN; G = G_; c = c_; parts = parts_; }
    __device__ bool next(int i, Unit& u) const {
        const int ti = (parts == 2) ? (i >> 1) : i; u.part = (parts == 2) ? (i & 1) : 0;
        const long L = (long)ti * G + c; if (L >= nwg) return false;
        int wgid = (int)L; { const int q = nwg / NXCD, r = nwg % NXCD, xcd = wgid % NXCD, off = wgid / NXCD; wgid = (xcd < r ? xcd * (q + 1) : r * (q + 1) + (xcd - r) * q) + off; }
        const int nig = WGM * nN, gid = wgid / nig, fm = gid * WGM, gsz = (nM - fm) < WGM ? (nM - fm) : WGM;
        u.pm = fm + ((wgid % nig) % gsz); u.pn = (wgid % nig) / gsz; return true;
    }
};

struct Ptrs {
    const bf16_t* A0; const bf16_t* B0; const bf16_t* A1; const bf16_t* B1; int lda, ldb;
    __device__ __forceinline__ const char* a(const Unit& u) const { return (const char*)((u.part ? A1 : A0) + (size_t)u.pm * BM * lda); }
    __device__ __forceinline__ const char* b(const Unit& u) const { return (const char*)((u.part ? B1 : B0) + (size_t)u.pn * BM * ldb); }
};

__device__ __forceinline__ unsigned cvt_pk_bf16(float lo, float hi) { unsigned r; asm volatile("v_cvt_pk_bf16_f32 %0, %1, %2" : "=v"(r) : "v"(lo), "v"(hi)); return r; }
__device__ __forceinline__ float bf_lo(unsigned w) { return __builtin_bit_cast(float, w << 16); }
__device__ __forceinline__ float bf_hi(unsigned w) { return __builtin_bit_cast(float, w & 0xffff0000u); }
__device__ __forceinline__ float sigmoidf_(float x) { return __builtin_amdgcn_rcpf(1.0f + __builtin_amdgcn_exp2f(-1.4426950409f * x)); }

typedef f32x4 Acc[2][2][4][2];

__device__ __forceinline__ u32x4 pack8(const f32x4& v0, const f32x4& v1) { u32x4 w; w.x = cvt_pk_bf16(v0[0], v0[1]); w.y = cvt_pk_bf16(v0[2], v0[3]); w.z = cvt_pk_bf16(v1[0], v1[1]); w.w = cvt_pk_bf16(v1[2], v1[3]); return w; }

struct EpiF32 {
    static constexpr bool PERM = false;
    float* C; int ldc; const float* bias;
    __device__ __forceinline__ bool keep(const Unit&) const { return false; }
    __device__ __forceinline__ void operator()(Acc& acc, const Unit& u, int wr, int wc, int fr, int fq) const {
        const int row0 = u.pm * BM + wr * 64 + fr, col0 = u.pn * BM + wc * 32 + 4 * fq;
        f32x4 bv[2][2];
#pragma unroll
        for (int bj = 0; bj < 2; ++bj)
#pragma unroll
            for (int n = 0; n < 2; ++n) bv[bj][n] = *(const f32x4*)(bias + col0 + bj * HALF + n * 16);
#pragma unroll
        for (int ai = 0; ai < 2; ++ai)
#pragma unroll
            for (int m = 0; m < 4; ++m) { float* rowp = C + (size_t)(row0 + ai * HALF + m * 16) * ldc + col0;
#pragma unroll
                for (int bj = 0; bj < 2; ++bj)
#pragma unroll
                    for (int n = 0; n < 2; ++n) *(f32x4*)(rowp + bj * HALF + n * 16) = acc[ai][bj][m][n] + bv[bj][n]; }
    }
};

struct EpiBf16 {
    static constexpr bool PERM = true;
    bf16_t* O; int ldc;
    __device__ __forceinline__ bool keep(const Unit&) const { return false; }
    __device__ __forceinline__ void operator()(Acc& acc, const Unit& u, int wr, int wc, int fr, int fq) const {
        const int row0 = u.pm * BM + wr * 64 + fr, col0 = u.pn * BM + wc * 32 + 8 * fq;
#pragma unroll
        for (int ai = 0; ai < 2; ++ai)
#pragma unroll
            for (int m = 0; m < 4; ++m) { bf16_t* rowp = O + (size_t)(row0 + ai * HALF + m * 16) * ldc + col0;
#pragma unroll
                for (int bj = 0; bj < 2; ++bj) *(u32x4*)(rowp + bj * HALF) = pack8(acc[ai][bj][m][0], acc[ai][bj][m][1]); }
    }
};

struct EpiIn {
    static constexpr bool PERM = true;
    bf16_t *U, *V, *BG, *P, *SGA, *SGB; float* VSS;
    __device__ __forceinline__ bool keep(const Unit&) const { return false; }
    __device__ __forceinline__ void operator()(Acc& acc, const Unit& u, int wr, int wc, int fr, int fq) const {
        const int row0 = u.pm * BM + wr * 64 + fr; const int pn = u.pn;
        if (pn >= 24 && pn < 40) {
            const int col0 = (pn - 24) * HALF + wc * 32 + 8 * fq;
#pragma unroll
            for (int ai = 0; ai < 2; ++ai)
#pragma unroll
                for (int m = 0; m < 4; ++m) {
                    const f32x4 p0 = acc[ai][0][m][0] * acc[ai][1][m][0], p1 = acc[ai][0][m][1] * acc[ai][1][m][1];
                    *(u32x4*)(P + (size_t)(row0 + ai * HALF + m * 16) * DM + col0) = pack8(p0, p1); }
            return;
        }
        bf16_t* O; int ct; bool sig = false, ss = false;
        if (pn < 8) { O = U; ct = pn; } else if (pn < 16) { O = V; ct = pn - 8; ss = true; } else if (pn < 24) { O = BG; ct = pn - 16; }
        else if (pn < 48) { O = SGA; ct = pn - 40; sig = true; } else { O = SGB; ct = pn - 48; sig = true; }
        const int col0 = ct * BM + wc * 32 + 8 * fq;
#pragma unroll
        for (int ai = 0; ai < 2; ++ai)
#pragma unroll
            for (int m = 0; m < 4; ++m) {
                const int row = row0 + ai * HALF + m * 16; bf16_t* rowp = O + (size_t)row * DM + col0;
                if (ss) { float s = 0.f;
#pragma unroll
                    for (int bj = 0; bj < 2; ++bj)
#pragma unroll
                        for (int n = 0; n < 2; ++n) { const f32x4 x = acc[ai][bj][m][n]; s += (x[0] * x[0] + x[1] * x[1]) + (x[2] * x[2] + x[3] * x[3]); }
                    s += __shfl_xor(s, 16); s += __shfl_xor(s, 32);
                    if (fq == 0) VSS[(size_t)row * 32 + ct * 4 + wc] = s; }
#pragma unroll
                for (int bj = 0; bj < 2; ++bj) { f32x4 v0 = acc[ai][bj][m][0], v1 = acc[ai][bj][m][1];
                    if (sig) {
#pragma unroll
                        for (int i = 0; i < 4; ++i) { v0[i] = sigmoidf_(v0[i]); v1[i] = sigmoidf_(v1[i]); } }
                    *(u32x4*)(rowp + bj * HALF) = pack8(v0, v1); } }
    }
};

struct EpiOut {
    static constexpr bool PERM = true;
    const bf16_t *SGA, *SGB; bf16_t* O;
    __device__ __forceinline__ bool keep(const Unit& u) const { return u.part == 0; }
    __device__ __forceinline__ void operator()(Acc& acc, const Unit& u, int wr, int wc, int fr, int fq) const {
        const int row0 = u.pm * BM + wr * 64 + fr, col0 = u.pn * BM + wc * 32 + 8 * fq;
#pragma unroll
        for (int ai = 0; ai < 2; ++ai)
#pragma unroll
            for (int m = 0; m < 4; ++m) { const size_t off = (size_t)(row0 + ai * HALF + m * 16) * DM + col0;
#pragma unroll
                for (int bj = 0; bj < 2; ++bj) {
                    const u32x4 a = *(const u32x4*)(SGA + off + bj * HALF);
                    f32x4 a0 = {bf_lo(a.x), bf_hi(a.x), bf_lo(a.y), bf_hi(a.y)}, a1 = {bf_lo(a.z), bf_hi(a.z), bf_lo(a.w), bf_hi(a.w)};
                    if (u.part == 0) {
                        const u32x4 b = *(const u32x4*)(SGB + off + bj * HALF);
                        const f32x4 b0 = {bf_lo(b.x), bf_hi(b.x), bf_lo(b.y), bf_hi(b.y)}, b1 = {bf_lo(b.z), bf_hi(b.z), bf_lo(b.w), bf_hi(b.w)};
#pragma unroll
                        for (int i = 0; i < 4; ++i) { acc[ai][bj][m][0][i] *= b0[i] * __builtin_amdgcn_rcpf(a0[i]); acc[ai][bj][m][1][i] *= b1[i] * __builtin_amdgcn_rcpf(a1[i]); }
                    } else {
                        *(u32x4*)(O + off + bj * HALF) = pack8(acc[ai][bj][m][0] * a0, acc[ai][bj][m][1] * a1);
                    } }
                asm volatile("" ::: "memory"); }
    }
};

__device__ __forceinline__ float gelu_fast(float x) { const float z = x + 0.044715f * x * x * x; return x * __builtin_amdgcn_rcpf(1.0f + __builtin_amdgcn_exp2f(-2.3022082f * z)); }
__device__ __forceinline__ float lane_get(float v, int addr4) { return __builtin_bit_cast(float, __builtin_amdgcn_ds_bpermute(addr4, __builtin_bit_cast(int, v))); }
struct EpiUpF {
    static constexpr bool PERM = true;
    bf16_t* G; float *SA, *SB, *SAS, *SBS; const float* cw;
    __device__ __forceinline__ bool keep(const Unit&) const { return false; }
    __device__ __forceinline__ void operator()(Acc& acc, const Unit& u, int wr, int wc, int fr, int fq) const {
        const int col0 = u.pn * HALF + wc * 32 + 8 * fq;
        if (u.pm >= MP / BM) {
#pragma unroll
            for (int ai = 0; ai < 2; ++ai)
#pragma unroll
                for (int m = 0; m < 4; ++m) { const size_t off = (size_t)(u.pm * BM - MP + ai * HALF + wr * 64 + m * 16 + fr) * DFF + col0;
                    *(f32x4*)(SAS + off) = acc[ai][0][m][0]; *(f32x4*)(SAS + off + 4) = acc[ai][0][m][1];
                    *(f32x4*)(SBS + off) = acc[ai][1][m][0]; *(f32x4*)(SBS + off + 4) = acc[ai][1][m][1]; }
            return;
        }
        f32x4 w0[2], w1[2], w2[2];
#pragma unroll
        for (int n = 0; n < 2; ++n) { w0[n] = *(const f32x4*)(cw + col0 + 4 * n); w1[n] = *(const f32x4*)(cw + DFF + col0 + 4 * n); w2[n] = *(const f32x4*)(cw + 2 * DFF + col0 + 4 * n); }
#pragma unroll
        for (int ai = 0; ai < 2; ++ai) {
            const int rb64 = u.pm * 4 + ai * 2 + wr;
#pragma unroll
            for (int m = 0; m < 4; ++m) {
                f32x4 gv[2];
#pragma unroll
                for (int n = 0; n < 2; ++n) {
                    const f32x4 a = acc[ai][0][m][n], b = acc[ai][1][m][n];
#pragma unroll
                    for (int i = 0; i < 4; ++i) {
                        const float av_ = a[i]; const int ai_ = __builtin_bit_cast(int, av_);
                        int o1 = 0, o2 = 0;
                        if (m > 0) { const float pf_ = acc[ai][0][m > 0 ? m - 1 : 0][n][i]; const int pv = __builtin_bit_cast(int, pf_);
                            o1 = __builtin_amdgcn_update_dpp(0, pv, 0x140, 0xf, 0xf, true);
                            o2 = __builtin_amdgcn_update_dpp(0, o1, 0xB1, 0xf, 0xf, true); }
                        const float p1 = __builtin_bit_cast(float, __builtin_amdgcn_update_dpp(o1, ai_, 0x111, 0xf, 0xf, false));
                        const float p2 = __builtin_bit_cast(float, __builtin_amdgcn_update_dpp(o2, ai_, 0x112, 0xf, 0xf, false));
                        const float y = w0[n][i] * p2 + w1[n][i] * p1 + w2[n][i] * a[i];
                        gv[n][i] = gelu_fast(y) * b[i];
                    }
                }
                const int row = u.pm * BM + ai * HALF + wr * 64 + m * 16 + fr;
                if (!(m == 0 && fr < 2)) *(u32x4*)(G + (size_t)row * DFF + col0) = pack8(gv[0], gv[1]);
                if (m == 0 && fr < 2) { float* pa = SA + (size_t)(rb64 * 4 + 2 + fr) * DFF + col0; float* pb = SB + (size_t)(rb64 * 2 + fr) * DFF + col0;
                    *(f32x4*)pa = acc[ai][0][0][0]; *(f32x4*)(pa + 4) = acc[ai][0][0][1]; *(f32x4*)pb = acc[ai][1][0][0]; *(f32x4*)(pb + 4) = acc[ai][1][0][1]; }
                if (m == 3 && fr >= 14) { float* pa = SA + (size_t)(rb64 * 4 + (fr - 14)) * DFF + col0; *(f32x4*)pa = acc[ai][0][3][0]; *(f32x4*)(pa + 4) = acc[ai][0][3][1]; }
            }
        }
    }
};

template <class Epi, class Sched, bool ALIGN_EPI, bool SP2>
__device__ __forceinline__ void gemm_phase(LAS unsigned char* lds, const Ptrs g, const int K, const Sched& S, const Epi& E) {
    const int tid = threadIdx.x, wid = __builtin_amdgcn_readfirstlane(tid >> 6), lane = tid & 63, wr = wid >> 2, wc = wid & 3, fr = lane & 15, fq = lane >> 4;
    const int nt = K / BK;
    unsigned voffA[2], voffB[2];
#pragma unroll
    for (int i = 0; i < 2; ++i) { int R, C; stage_rc(tid * 16 + i * 8192, R, C); const int Rb = Epi::PERM ? ((R & ~31) + perm32(R & 31)) : R;
        voffA[i] = (unsigned)(R * g.lda + C) * 2u; voffB[i] = (unsigned)(Rb * g.ldb + C) * 2u; }
    const size_t kstep = (size_t)(BK * 2);
    const size_t hstepA = (size_t)HALF * g.lda * 2, hstepB = (size_t)HALF * g.ldb * 2;
    const unsigned ldsw = (unsigned)wid * 1024u;
    const int aoff = lds_byte(wr * 64 + fr, fq * 8), boff = lds_byte(wc * 32 + fr, fq * 8);
#define PG8_SA(b, h) (((b) * 2 + (h)) * HTB)
#define PG8_SB(b, h) ((4 + (b) * 2 + (h)) * HTB)
#define PG8_STAGE(bufoff, gbase, voff) do { _Pragma("unroll") for (int _i = 0; _i < 2; ++_i) \
        __builtin_amdgcn_global_load_lds((const unsigned*)((const char*)(gbase) + (voff)[_i]), (LAS unsigned*)(lds + (bufoff) + ldsw + _i * 8192), 16, 0, 0); } while (0)
#define PG8_LDA(dst, b, h) do { _Pragma("unroll") for (int m = 0; m < 4; ++m) _Pragma("unroll") for (int k = 0; k < 2; ++k) dst[m][k] = *(const LAS bf16x8*)(lds + PG8_SA(b, h) + aoff + m * 2048 + k * 1024); } while (0)
#define PG8_LDB(dst, b, h) do { _Pragma("unroll") for (int n = 0; n < 2; ++n) _Pragma("unroll") for (int k = 0; k < 2; ++k) dst[n][k] = *(const LAS bf16x8*)(lds + PG8_SB(b, h) + boff + n * 2048 + k * 1024); } while (0)
#define PG8_MMA(ai, bj, At, Bt) do { __builtin_amdgcn_s_setprio(1); _Pragma("unroll") for (int m = 0; m < 4; ++m) _Pragma("unroll") for (int n = 0; n < 2; ++n) _Pragma("unroll") for (int k = 0; k < 2; ++k) \
        acc[ai][bj][m][n] = __builtin_amdgcn_mfma_f32_16x16x32_bf16(Bt[n][k], At[m][k], acc[ai][bj][m][n], 0, 0, 0); __builtin_amdgcn_s_setprio(0); } while (0)
#define PG8_WAIT_V(n) asm volatile("s_waitcnt vmcnt(" #n ")" ::: "memory")
#define PG8_WAIT_L(n) asm volatile("s_waitcnt lgkmcnt(" #n ")" ::: "memory")
#define PG8_BAR __builtin_amdgcn_s_barrier()
#define PG8_SCHED __builtin_amdgcn_sched_barrier(0)
    Unit cur, nxt; int ui = 0;
    if (!S.next(0, cur)) return;
    Acc acc;
#pragma unroll
    for (int a = 0; a < 2; ++a)
#pragma unroll
        for (int b = 0; b < 2; ++b)
#pragma unroll
            for (int m = 0; m < 4; ++m)
#pragma unroll
                for (int n = 0; n < 2; ++n) acc[a][b][m][n] = (f32x4){0.f, 0.f, 0.f, 0.f};
    bf16x8 At[4][2], B0[2][2], B1[2][2];
    const char* cA = g.a(cur); const char* cB = g.b(cur);
    if constexpr (SP2) {
        PG8_STAGE(PG8_SB(0, 0), cB, voffB); PG8_STAGE(PG8_SB(0, 1), cB + hstepB, voffB); PG8_STAGE(PG8_SA(0, 0), cA, voffA); PG8_STAGE(PG8_SA(0, 1), cA + hstepA, voffA);
        if (wr == 1) PG8_BAR;
        PG8_WAIT_V(2); PG8_BAR;
        PG8_STAGE(PG8_SB(1, 0), cB + kstep, voffB); PG8_STAGE(PG8_SA(1, 0), cA + kstep, voffA); PG8_STAGE(PG8_SB(1, 1), cB + hstepB + kstep, voffB);
        PG8_WAIT_V(6); PG8_BAR;
    } else {
        PG8_STAGE(PG8_SB(0, 0), cB, voffB); PG8_STAGE(PG8_SA(0, 0), cA, voffA); PG8_STAGE(PG8_SB(0, 1), cB + hstepB, voffB); PG8_STAGE(PG8_SA(0, 1), cA + hstepA, voffA);
        if (wr == 1) PG8_BAR;
        PG8_WAIT_V(4); PG8_BAR;
        PG8_STAGE(PG8_SB(1, 0), cB + kstep, voffB); PG8_STAGE(PG8_SA(1, 0), cA + kstep, voffA); PG8_STAGE(PG8_SB(1, 1), cB + hstepB + kstep, voffB);
        PG8_WAIT_V(6); PG8_BAR;
    }
    for (;;) {
        const bool has_next = S.next(ui + 1, nxt);
        const char* nA = has_next ? g.a(nxt) : cA; const char* nB = has_next ? g.b(nxt) : cB;
        for (int t = 0; t < nt; t += 2) {
            const bool last = (t == nt - 2);
            const char* a1 = cA + (size_t)(t + 1) * kstep;
            const char* a2 = last ? nA : cA + (size_t)(t + 2) * kstep; const char* b2 = last ? nB : cB + (size_t)(t + 2) * kstep;
            const char* a3 = a2 + kstep; const char* b3 = b2 + kstep;
            if constexpr (SP2) {
            PG8_LDB(B0, 0, 0); PG8_LDB(B1, 0, 1); PG8_SCHED; PG8_LDA(At, 0, 0); PG8_STAGE(PG8_SA(1, 1), a1 + hstepA, voffA);
            PG8_WAIT_V(8); PG8_WAIT_L(0); PG8_BAR; PG8_MMA(0, 0, At, B0); PG8_MMA(0, 1, At, B1); PG8_BAR; PG8_SCHED;
            PG8_LDA(At, 0, 1); PG8_STAGE(PG8_SB(0, 0), b2, voffB); PG8_STAGE(PG8_SB(0, 1), b2 + hstepB, voffB); PG8_STAGE(PG8_SA(0, 0), a2, voffA);
            PG8_WAIT_V(8); PG8_WAIT_L(0); PG8_BAR; PG8_MMA(1, 0, At, B0); PG8_MMA(1, 1, At, B1); PG8_BAR; PG8_SCHED;
            PG8_LDB(B0, 1, 0); PG8_LDB(B1, 1, 1); PG8_SCHED; PG8_LDA(At, 1, 0); PG8_STAGE(PG8_SA(0, 1), a2 + hstepA, voffA);
            PG8_WAIT_V(8); PG8_WAIT_L(0); PG8_BAR; PG8_MMA(0, 0, At, B0); PG8_MMA(0, 1, At, B1); PG8_BAR; PG8_SCHED;
            PG8_LDA(At, 1, 1); PG8_STAGE(PG8_SB(1, 0), b3, voffB); PG8_STAGE(PG8_SB(1, 1), b3 + hstepB, voffB); PG8_STAGE(PG8_SA(1, 0), a3, voffA);
            PG8_WAIT_V(8); PG8_WAIT_L(0); PG8_BAR; PG8_MMA(1, 0, At, B0); PG8_MMA(1, 1, At, B1); PG8_BAR; PG8_SCHED;
            } else {
            PG8_LDB(B0, 0, 0); PG8_SCHED; PG8_LDA(At, 0, 0); PG8_STAGE(PG8_SA(1, 1), a1 + hstepA, voffA);
            PG8_WAIT_L(8); PG8_BAR; PG8_WAIT_L(0); PG8_MMA(0, 0, At, B0); PG8_BAR; PG8_SCHED;
            PG8_LDB(B1, 0, 1); PG8_STAGE(PG8_SB(0, 0), b2, voffB);
            PG8_BAR; PG8_WAIT_L(0); PG8_MMA(0, 1, At, B1); PG8_BAR;
            PG8_LDA(At, 0, 1); PG8_STAGE(PG8_SA(0, 0), a2, voffA);
            PG8_BAR; PG8_WAIT_L(0); PG8_MMA(1, 0, At, B0); PG8_BAR; PG8_SCHED;
            PG8_STAGE(PG8_SB(0, 1), b2 + hstepB, voffB);
            PG8_WAIT_V(6); PG8_BAR; PG8_MMA(1, 1, At, B1); PG8_BAR;
            PG8_LDB(B0, 1, 0); PG8_SCHED; PG8_LDA(At, 1, 0); PG8_STAGE(PG8_SA(0, 1), a2 + hstepA, voffA);
            PG8_WAIT_L(8); PG8_BAR; PG8_WAIT_L(0); PG8_MMA(0, 0, At, B0); PG8_BAR; PG8_SCHED;
            PG8_LDB(B1, 1, 1); PG8_STAGE(PG8_SB(1, 0), b3, voffB);
            PG8_BAR; PG8_WAIT_L(0); PG8_MMA(0, 1, At, B1); PG8_BAR;
            PG8_LDA(At, 1, 1); PG8_STAGE(PG8_SA(1, 0), a3, voffA);
            PG8_BAR; PG8_WAIT_L(0); PG8_MMA(1, 0, At, B0); PG8_BAR; PG8_SCHED;
            PG8_STAGE(PG8_SB(1, 1), b3 + hstepB, voffB);
            PG8_WAIT_V(6); PG8_BAR; PG8_MMA(1, 1, At, B1); PG8_BAR;
            }
        }
        if constexpr (ALIGN_EPI) { if (wr == 0) PG8_BAR; }
        E(acc, cur, wr, wc, fr, fq);
        if (!E.keep(cur)) {
#pragma unroll
            for (int a = 0; a < 2; ++a)
#pragma unroll
                for (int b = 0; b < 2; ++b)
#pragma unroll
                    for (int m = 0; m < 4; ++m)
#pragma unroll
                        for (int n = 0; n < 2; ++n) acc[a][b][m][n] = (f32x4){0.f, 0.f, 0.f, 0.f};
        }
        if (!has_next) break;
        cur = nxt; cA = nA; cB = nB; ++ui;
        if constexpr (ALIGN_EPI) { if (wr == 1) PG8_BAR; }
    }
    PG8_WAIT_V(0);
    if constexpr (!ALIGN_EPI) { if (wr == 0) PG8_BAR; }
    PG8_BAR;
#undef PG8_SA
#undef PG8_SB
#undef PG8_STAGE
#undef PG8_LDA
#undef PG8_LDB
#undef PG8_MMA
#undef PG8_WAIT_V
#undef PG8_WAIT_L
#undef PG8_BAR
#undef PG8_SCHED
}
}


namespace sg {
struct EpiSum {
    bf16_t* O; int ldc;
    __device__ __forceinline__ void operator()(int row, int col, const f32x4& s0, const f32x4& s1) const {
        const f32x4 r = s0 + s1; u32x2 o; o.x = pg8::cvt_pk_bf16(r[0], r[1]); o.y = pg8::cvt_pk_bf16(r[2], r[3]);
        *(u32x2*)(O + (size_t)row * ldc + col) = o; }
};
struct EpiOutS {
    const bf16_t *SGA, *SGB; bf16_t* O;
    __device__ __forceinline__ void operator()(int row, int col, const f32x4& s0, const f32x4& s1) const {
        const size_t off = (size_t)row * DM + col; const u32x2 a = *(const u32x2*)(SGA + off), b = *(const u32x2*)(SGB + off);
        const f32x4 av = {pg8::bf_lo(a.x), pg8::bf_hi(a.x), pg8::bf_lo(a.y), pg8::bf_hi(a.y)}, bv = {pg8::bf_lo(b.x), pg8::bf_hi(b.x), pg8::bf_lo(b.y), pg8::bf_hi(b.y)};
        const f32x4 r = av * s1 + bv * s0; u32x2 o; o.x = pg8::cvt_pk_bf16(r[0], r[1]); o.y = pg8::cvt_pk_bf16(r[2], r[3]);
        *(u32x2*)(O + off) = o; }
};
struct EpiF32B {
    float* C; int ldc; const float* bias;
    __device__ __forceinline__ void operator()(int row, int col, const f32x4& s0, const f32x4& s1) const {
        *(f32x4*)(C + (size_t)row * ldc + col) = s0 + s1 + *(const f32x4*)(bias + col); }
};
template <class Epi>
__device__ __forceinline__ void small_gemm(LAS unsigned char* lds, const bf16_t* A0, const bf16_t* B0, const bf16_t* A1, const bf16_t* B1,
                                           const int lda, const int ldb, const int K, const int parts, const int row0, const int col0, const Epi& E) {
    const int tid = threadIdx.x, w = __builtin_amdgcn_readfirstlane(tid >> 6), lane = tid & 63, fr = lane & 15, fq = lane >> 4;
    const int part = parts == 2 ? (w >> 2) : 0, kw = parts == 2 ? (w & 3) : w, klen = parts == 2 ? K / 4 : K / 8;
    const bf16_t* Ap = (part ? A1 : A0) + (size_t)(row0 + fr) * lda + kw * klen + 8 * fq;
    const bf16_t* Bp = (part ? B1 : B0) + (size_t)(col0 + fr) * ldb + kw * klen + 8 * fq;
    const int nsteps = klen / 32;
    f32x4 acc[4][4];
#pragma unroll
    for (int m = 0; m < 4; ++m)
#pragma unroll
        for (int n = 0; n < 4; ++n) acc[m][n] = (f32x4){0.f, 0.f, 0.f, 0.f};
    bf16x8 a0[4], b0[4], a1[4], b1[4];
#define SG_LD(av, bv, s) do { _Pragma("unroll") for (int m = 0; m < 4; ++m) { av[m] = *(const bf16x8*)(Ap + (size_t)(16 * m) * lda + 32 * (s)); bv[m] = *(const bf16x8*)(Bp + (size_t)(16 * m) * ldb + 32 * (s)); } } while (0)
#define SG_MM(av, bv) do { _Pragma("unroll") for (int m = 0; m < 4; ++m) _Pragma("unroll") for (int n = 0; n < 4; ++n) acc[m][n] = __builtin_amdgcn_mfma_f32_16x16x32_bf16(bv[n], av[m], acc[m][n], 0, 0, 0); } while (0)
    SG_LD(a0, b0, 0);
    for (int s = 0; s < nsteps; s += 2) {
        SG_LD(a1, b1, s + 1);
        SG_MM(a0, b0);
        if (s + 2 < nsteps) SG_LD(a0, b0, s + 2);
        SG_MM(a1, b1);
    }
#undef SG_LD
#undef SG_MM
#pragma unroll
    for (int m = 0; m < 4; ++m)
#pragma unroll
        for (int n = 0; n < 4; ++n) *(LAS f32x4*)(lds + (size_t)(((w * 16 + m * 4 + n) * 64 + lane) * 16)) = acc[m][n];
    __syncthreads();
#pragma unroll
    for (int q = 0; q < 2; ++q) {
        const int p = w + 8 * q; f32x4 s0 = {0.f, 0.f, 0.f, 0.f}, s1 = {0.f, 0.f, 0.f, 0.f};
#pragma unroll
        for (int ww = 0; ww < 4; ++ww) { s0 += *(const LAS f32x4*)(lds + (size_t)(((ww * 16 + p) * 64 + lane) * 16)); s1 += *(const LAS f32x4*)(lds + (size_t)((((ww + 4) * 16 + p) * 64 + lane) * 16)); }
        const int m = p >> 2, n = p & 3;
        E(row0 + 16 * m + fr, col0 + 16 * n + 4 * fq, s0, s1);
    }
    __syncthreads();
}
}

constexpr int NWAVES = 8;
#ifndef MK_N_LAUNCHES
#define MK_N_LAUNCHES 1
#endif
constexpr int NPHASES = 12;
constexpr int N_LAUNCHES = MK_N_LAUNCHES;
constexpr bool K_SP2 = true, K_ALIGN = true;

constexpr int CW_BAR = 4096;
constexpr int RING_OFF = 0, RING_BYTES = 131072;
constexpr int LDSCTL_OFF = RING_BYTES, MISC_OFF = LDSCTL_OFF + 320;
constexpr int LDS_BYTES = 147456;

typedef GAS unsigned gu32;
#define RLX_AGENT __ATOMIC_RELAXED, __HIP_MEMORY_SCOPE_AGENT
#define LDS_WAIT() asm volatile("s_waitcnt lgkmcnt(0)" ::: "memory")
#define VM_WAIT() asm volatile("s_waitcnt vmcnt(0)" ::: "memory")
__device__ __forceinline__ unsigned f2bf(float f) { unsigned u = __builtin_bit_cast(unsigned, f); return (u + 0x7fffu + ((u >> 16) & 1u)) >> 16; }
__device__ __forceinline__ unsigned pk2(float lo, float hi) { return f2bf(lo) | (f2bf(hi) << 16); }
using pg8::bf_lo; using pg8::bf_hi;

#define XB_TMO      128
#define XB_XCNT(j)  (256  + 64 * (j))
#define XB_XSUB(j)  (1280 + 64 * (j))
#define XB_XGEN(j)  (2304 + 64 * (j))
#define XB_TOP      3328
#define XB_TOPGEN   3392
#define XCD_BAR_WORDS 3456
#define XB_SPIN_CAP (1u << 22)
__device__ __forceinline__ unsigned xb_ld(unsigned* p)              { return __hip_atomic_load(p, __ATOMIC_RELAXED, __HIP_MEMORY_SCOPE_AGENT); }
__device__ __forceinline__ unsigned xb_add(unsigned* p, unsigned v) { return __hip_atomic_fetch_add(p, v, __ATOMIC_RELAXED, __HIP_MEMORY_SCOPE_AGENT); }
__device__ __forceinline__ unsigned xb_xcc_id() { return (unsigned)__builtin_amdgcn_s_getreg((3 << 11) | 20) & 0xFu; }
#define XB_SPIN(cond, bar) do { unsigned _sp = 0; while (cond) { __builtin_amdgcn_s_sleep(1); \
    if ((++_sp & 255u) == 0u) { if (xb_ld(&(bar)[XB_TMO])) break; if (_sp > XB_SPIN_CAP) { atomicAdd(&(bar)[XB_TMO], 1u); break; } } } } while (0)
struct XcdBarrier { unsigned* bar; unsigned x; volatile LAS unsigned* st; };
__device__ __forceinline__ XcdBarrier xcd_barrier_post(unsigned* bar, volatile LAS unsigned* st) {
    XcdBarrier b; b.bar = bar; b.x = xb_xcc_id(); b.st = st;
    if (threadIdx.x == 0) (void)xb_add(&bar[XB_XCNT(b.x)], 1u);
    return b;
}
__device__ __forceinline__ void xcd_barrier_complete(unsigned* bar, unsigned x, unsigned& nloc, unsigned& nx) {
    const unsigned G = gridDim.x * gridDim.y * gridDim.z;
    unsigned sum, cnt, mine, sp = 0u;
    for (;;) {
        sum = 0u; cnt = 0u; mine = 0u;
#pragma unroll
        for (unsigned j = 0; j < 16; ++j) { const unsigned c = xb_ld(&bar[XB_XCNT(j)]); sum += c; cnt += (c > 0u) ? 1u : 0u; mine = (j == x) ? c : mine; }
        if (sum == G) break;
        __builtin_amdgcn_s_sleep(1);
        if ((++sp & 255u) == 0u) { if (xb_ld(&bar[XB_TMO])) break; if (sp > XB_SPIN_CAP) { atomicAdd(&bar[XB_TMO], 1u); break; } }
    }
    nloc = mine > 0u ? mine : 1u; nx = cnt > 0u ? cnt : 1u;
}
__device__ __forceinline__ void xcd_barrier(const XcdBarrier& b) {
    asm volatile("s_waitcnt vmcnt(0)" ::: "memory");
    __syncthreads();
    if (threadIdx.x == 0) {
        unsigned* bar = b.bar;
        __builtin_amdgcn_s_waitcnt(0);
        unsigned nloc = b.st[0], nx = b.st[1];
        if (nloc == 0u) { xcd_barrier_complete(bar, b.x, nloc, nx); b.st[0] = nloc; b.st[1] = nx; }
        const unsigned old = xb_add(&bar[XB_XSUB(b.x)], 1u);
        const unsigned gen = old / nloc;
        if (old + 1u == (gen + 1u) * nloc) {
            __builtin_amdgcn_fence(__ATOMIC_RELEASE, "agent");
            asm volatile("s_waitcnt vmcnt(0)" ::: "memory");
            const unsigned og = xb_add(&bar[XB_TOP], 1u);
            const unsigned tg = og / nx;
            if (og + 1u == (tg + 1u) * nx) xb_add(&bar[XB_TOPGEN], 1u);
            else XB_SPIN(xb_ld(&bar[XB_TOPGEN]) == tg, bar);
            __builtin_amdgcn_fence(__ATOMIC_ACQUIRE, "agent");
            xb_add(&bar[XB_XGEN(b.x)], 1u);
            asm volatile("s_waitcnt vmcnt(0)" ::: "memory");
        } else {
            XB_SPIN(xb_ld(&bar[XB_XGEN(b.x)]) == gen, bar);
            __builtin_amdgcn_fence(__ATOMIC_ACQUIRE, "agent");
            asm volatile("s_waitcnt vmcnt(0)" ::: "memory");
        }
    }
    __syncthreads();
}

struct Args { const float* in[23]; float* out; unsigned char* ws; int ph_lo, ph_hi, li, pad; };
struct Frame {
    LAS unsigned char* lds;
    int tid, lane, wave, vcu, G;
    const float* const* in;
    float* out; unsigned char* ws;
};
__device__ __forceinline__ float wave_sum(float v) {
#pragma unroll
    for (int o = 1; o < 64; o <<= 1) v += __shfl_xor(v, o);
    return v;
}
__device__ __forceinline__ float sigm(float x) { return 1.0f / (1.0f + __expf(-x)); }
__device__ __forceinline__ float gelu_tanh(float x) { const float z = 1.5957691216f * (x + 0.044715f * x * x * x); return x / (1.0f + __expf(-z)); }

__device__ __forceinline__ void p0_transpose_item(const float* W, int K, int N, bf16_t* WT, int k0, int n0, int drow0, LAS float* scr, int lane) {
#pragma unroll 8
    for (int i = 0; i < 32; ++i) { const int kk = 2 * i + (lane >> 5); scr[kk * 33 + (lane & 31)] = W[(size_t)(k0 + kk) * N + n0 + (lane & 31)]; }
    LDS_WAIT(); asm volatile("" ::: "memory");
    const int c = lane & 7;
#pragma unroll
    for (int j = 0; j < 4; ++j) { const int n = (lane >> 3) + 8 * j; const LAS float* s = scr + (8 * c) * 33 + n;
        u32x4 o; o.x = pk2(s[0 * 33], s[1 * 33]); o.y = pk2(s[2 * 33], s[3 * 33]); o.z = pk2(s[4 * 33], s[5 * 33]); o.w = pk2(s[6 * 33], s[7 * 33]);
        *(GAS u32x4*)(WT + (size_t)(drow0 + n) * K + k0 + 8 * c) = o; }
    LDS_WAIT(); asm volatile("" ::: "memory");
}
__device__ __forceinline__ int win_drow(int n0) {
    const int seg = n0 >> 11, off = n0 & 2047;
    if (seg == 3) return 6144 + (off >> 7) * 256 + (off & 127);
    if (seg == 4) return 6144 + (off >> 7) * 256 + 128 + (off & 127);
    return n0;
}
__device__ __forceinline__ int wup_drow(int n0) {
    const int seg = n0 >= DFF ? 1 : 0, off = n0 - seg * DFF;
    return (off >> 7) * 256 + seg * 128 + (off & 127);
}
__device__ __forceinline__ void p0_prologue(Frame& F) {
    LAS float* scr = (LAS float*)(F.lds + RING_OFF + F.wave * 16384);
    const int gw = F.vcu * NWAVES + F.wave, NGW = F.G * NWAVES;
    const float* w_ada = F.in[6]; const float* w_in = F.in[10]; const float* w_out_a = F.in[15]; const float* w_out_b = F.in[16]; const float* w_o = F.in[17];
    const float* w_up = F.in[20]; const float* w_down = F.in[22];
    bf16_t* WinT = (bf16_t*)(F.ws + WS_WIN); bf16_t* WadaT = (bf16_t*)(F.ws + WS_WADA); bf16_t* WbT = (bf16_t*)(F.ws + WS_WB); bf16_t* WaT = (bf16_t*)(F.ws + WS_WA);
    bf16_t* WoT = (bf16_t*)(F.ws + WS_WO); bf16_t* WupT = (bf16_t*)(F.ws + WS_WUP); bf16_t* WdT = (bf16_t*)(F.ws + WS_WD);
    constexpr int I_ADA = (DM / 64) * (NMODC / 32), I_IN = (DM / 64) * (INW / 32), I_SQ = (DM / 64) * (DM / 32), I_UP = (DM / 64) * (2 * DFF / 32), I_DN = (DFF / 64) * (DM / 32);
    constexpr int NITEMS = I_ADA + I_IN + 3 * I_SQ + I_UP + I_DN;
    for (int it = gw; it < NITEMS; it += NGW) {
        int r = it;
        if (r < I_ADA) { const int nblk = NMODC / 32, kb = r / nblk, nb = r % nblk; p0_transpose_item(w_ada, DM, NMODC, WadaT, kb * 64, nb * 32, nb * 32, scr, F.lane); continue; } r -= I_ADA;
        if (r < I_IN) { const int nblk = INW / 32, kb = r / nblk, nb = r % nblk; p0_transpose_item(w_in, DM, INW, WinT, kb * 64, nb * 32, win_drow(nb * 32), scr, F.lane); continue; } r -= I_IN;
        if (r < I_SQ) { const int nblk = DM / 32, kb = r / nblk, nb = r % nblk; p0_transpose_item(w_out_b, DM, DM, WbT, kb * 64, nb * 32, nb * 32, scr, F.lane); continue; } r -= I_SQ;
        if (r < I_SQ) { const int nblk = DM / 32, kb = r / nblk, nb = r % nblk; p0_transpose_item(w_out_a, DM, DM, WaT, kb * 64, nb * 32, nb * 32, scr, F.lane); continue; } r -= I_SQ;
        if (r < I_SQ) { const int nblk = DM / 32, kb = r / nblk, nb = r % nblk; p0_transpose_item(w_o, DM, DM, WoT, kb * 64, nb * 32, nb * 32, scr, F.lane); continue; } r -= I_SQ;
        if (r < I_UP) { const int nblk = 2 * DFF / 32, kb = r / nblk, nb = r % nblk; p0_transpose_item(w_up, DM, 2 * DFF, WupT, kb * 64, nb * 32, wup_drow(nb * 32), scr, F.lane); continue; } r -= I_UP;
        { const int nblk = DM / 32, kb = r / nblk, nb = r % nblk; p0_transpose_item(w_down, DFF, DM, WdT, kb * 64, nb * 32, nb * 32, scr, F.lane); }
    }
    bf16_t* S = (bf16_t*)(F.ws + WS_S);
    const float* c_p = F.in[2]; const float* c_s = F.in[3];
    for (int r = gw; r < 256; r += NGW) {
        const float* src = r < NB ? c_p + (size_t)r * DM : c_s + (size_t)(r - NB) * DM;
#pragma unroll
        for (int j = 0; j < 8; ++j) { const int c = 4 * F.lane + 256 * j; u32x2 o = {0u, 0u};
            if (r < NBIDX) { const f32x4 v = *(const f32x4*)(src + c); o.x = pk2(v[0] * sigm(v[0]), v[1] * sigm(v[1])); o.y = pk2(v[2] * sigm(v[2]), v[3] * sigm(v[3])); }
            *(u32x2*)(S + (size_t)r * DM + c) = o; }
    }
}

__device__ __forceinline__ void p_h1(Frame& F) {
    const int gw = F.vcu * NWAVES + F.wave, NGW = F.G * NWAVES;
    const float* g_pre = F.in[8]; const float* MOD = (const float*)(F.ws + WS_MOD); bf16_t* H1 = (bf16_t*)(F.ws + WS_H1);
    for (int r = gw; r < M; r += NGW) {
        const float* xrow = r < MP ? F.in[0] + (size_t)r * DM : F.in[1] + (size_t)(r - MP) * DM;
        const int bidx = r < MP ? r / SEQ : NB + (r - MP) / DS;
        const float* mod = MOD + (size_t)bidx * NMODC;
        f32x4 v[8]; float s = 0.f;
#pragma unroll
        for (int j = 0; j < 8; ++j) { v[j] = *(const f32x4*)(xrow + 4 * F.lane + 256 * j); s += (v[j][0] * v[j][0] + v[j][1] * v[j][1]) + (v[j][2] * v[j][2] + v[j][3] * v[j][3]); }
        const float rstd = 1.0f / sqrtf(wave_sum(s) * (1.0f / DM) + EPS);
#pragma unroll
        for (int j = 0; j < 8; ++j) { const int c = 4 * F.lane + 256 * j;
            const f32x4 g = *(const f32x4*)(g_pre + c), sh = *(const f32x4*)(mod + c), sc = *(const f32x4*)(mod + DM + c);
            const f32x4 h = v[j] * rstd * g * (sc + 1.0f) + sh;
            u32x2 o; o.x = pk2(h[0], h[1]); o.y = pk2(h[2], h[3]);
            *(u32x2*)(H1 + (size_t)r * DM + c) = o; }
    }
}

__device__ __forceinline__ void unpack8(const u32x4& q, float (&x)[8]) { x[0] = bf_lo(q.x); x[1] = bf_hi(q.x); x[2] = bf_lo(q.y); x[3] = bf_hi(q.y); x[4] = bf_lo(q.z); x[5] = bf_hi(q.z); x[6] = bf_lo(q.w); x[7] = bf_hi(q.w); }
__device__ __forceinline__ void p_gate(Frame& F) {
    const bf16_t* U = (const bf16_t*)(F.ws + WS_U); const bf16_t* V = (const bf16_t*)(F.ws + WS_V); const bf16_t* BG = (const bf16_t*)(F.ws + WS_BG); const bf16_t* P = (const bf16_t*)(F.ws + WS_P);
    bf16_t* YA = (bf16_t*)(F.ws + WS_YA); bf16_t* YB = (bf16_t*)(F.ws + WS_YB); const float* VSS = (const float*)(F.ws + WS_VSS);
    const float* g_v = F.in[11]; const float* w_s = F.in[12]; const float* b_s = F.in[13]; const float* cbw = F.in[14]; const float* state = F.in[4];
    LAS float* rs = (LAS float*)(F.lds);
    LAS unsigned char* VT = F.lds + 1024;
    const int tid = F.tid, lane = F.lane, w = F.wave, fr = lane & 15, fq = lane >> 4;
    for (int it = F.vcu; it < (M / 128) * 16; it += F.G) {
        const int ch = it >> 4, g = it & 15, r0 = ch * 128; const bool sample = r0 >= MP;
        u32x4 v0[2], v1[2];
#pragma unroll
        for (int q = 0; q < 2; ++q) { const int idx = tid + 512 * q, cq = idx & 15, sp = idx >> 4; const bf16_t* p = V + (size_t)(r0 + 2 * sp) * DM + g * 128 + 8 * cq;
            v0[q] = *(const u32x4*)p; v1[q] = *(const u32x4*)(p + DM); }
        const int t = 16 * w + fr;
        u32x4 uu[4];
#pragma unroll
        for (int p = 0; p < 4; ++p) uu[p] = *(const u32x4*)(U + (size_t)(r0 + t) * DM + g * 128 + 32 * p + 8 * fq);
        const int cq2 = tid & 15, rg = tid >> 4, rc = r0 + 4 * rg, cc = g * 128 + 8 * cq2;
        u32x4 pp[4], bb[4]; float h2[8], h1[8];
#pragma unroll
        for (int k = 0; k < 4; ++k) { pp[k] = *(const u32x4*)(P + (size_t)(rc + k) * DM + cc); bb[k] = *(const u32x4*)(BG + (size_t)(rc + k) * DM + cc); }
        if (sample) { const int sb = (rc - MP) >> 2;
#pragma unroll
            for (int h = 0; h < 2; ++h) { const f32x4 s2 = *(const f32x4*)(state + ((size_t)sb * 2 + 0) * DM + cc + 4 * h), s1 = *(const f32x4*)(state + ((size_t)sb * 2 + 1) * DM + cc + 4 * h);
#pragma unroll
                for (int k = 0; k < 4; ++k) { h2[4 * h + k] = s2[k]; h1[4 * h + k] = s1[k]; } }
        } else if ((rc & (SEQ - 1)) == 0) {
#pragma unroll
            for (int k = 0; k < 8; ++k) { h2[k] = 0.f; h1[k] = 0.f; }
        } else { const u32x4 q2 = *(const u32x4*)(P + (size_t)(rc - 2) * DM + cc), q1 = *(const u32x4*)(P + (size_t)(rc - 1) * DM + cc); unpack8(q2, h2); unpack8(q1, h1); }
        if (tid < 128) { const f32x4* p = (const f32x4*)(VSS + (size_t)(r0 + tid) * 32); float s = 0.f;
#pragma unroll
            for (int q = 0; q < 8; ++q) { const f32x4 a = p[q]; s += (a[0] + a[1]) + (a[2] + a[3]); }
            rs[tid] = 1.0f / sqrtf(s * (1.0f / DM) + EPS); }
        __syncthreads();
#pragma unroll
        for (int q = 0; q < 2; ++q) { const int idx = tid + 512 * q, cq = idx & 15, sp = idx >> 4; const float rsd0 = rs[2 * sp], rsd1 = rs[2 * sp + 1];
            const f32x4 g0 = *(const f32x4*)(g_v + g * 128 + 8 * cq), g1 = *(const f32x4*)(g_v + g * 128 + 8 * cq + 4);
            float x0[8], x1[8]; unpack8(v0[q], x0); unpack8(v1[q], x1);
#pragma unroll
            for (int j = 0; j < 8; ++j) { const float gg = j < 4 ? g0[j & 3] : g1[j & 3]; x0[j] *= rsd0 * gg; x1[j] *= rsd1 * gg;
                const int c = 8 * cq + j;
                *(LAS unsigned*)(VT + c * 272 + (((sp >> 2) ^ cq) << 4) + ((sp & 3) << 2)) = pk2(x0[j], x1[j]); }
            if (sample) { float* cv = F.out + O_CV + (size_t)(r0 - MP + 2 * sp) * DM + g * 128 + 8 * cq;
                *(f32x4*)cv = (f32x4){x0[0], x0[1], x0[2], x0[3]}; *(f32x4*)(cv + 4) = (f32x4){x0[4], x0[5], x0[6], x0[7]};
                *(f32x4*)(cv + DM) = (f32x4){x1[0], x1[1], x1[2], x1[3]}; *(f32x4*)(cv + DM + 4) = (f32x4){x1[4], x1[5], x1[6], x1[7]}; } }
        __syncthreads();
        f32x4 acc[4][2];
#pragma unroll
        for (int p = 0; p < 4; ++p) { acc[p][0] = (f32x4){0.f, 0.f, 0.f, 0.f}; acc[p][1] = (f32x4){0.f, 0.f, 0.f, 0.f}; }
        const int kk_hi = w >> 1, kk_lo = sample ? kk_hi : 0;
        for (int kk = kk_lo; kk <= kk_hi; ++kk) {
            const int s0 = 32 * kk + 8 * fq;
            float wv[8];
            if (!sample) { const float* wp = w_s + ((size_t)g * 128 + t) * 128 + s0; const f32x4 wa = *(const f32x4*)wp, wb = *(const f32x4*)(wp + 4);
#pragma unroll
                for (int j = 0; j < 8; ++j) { const float x = j < 4 ? wa[j & 3] : wb[j & 3]; wv[j] = (s0 + j <= t) ? x : 0.f; }
            } else { const f32x4 w4 = *(const f32x4*)(w_s + ((size_t)g * 128 + (t & 3)) * 128);
#pragma unroll
                for (int j = 0; j < 8; ++j) { const int s = s0 + j; wv[j] = ((s >> 2) == (t >> 2) && (s & 3) <= (t & 3)) ? w4[j & 3] : 0.f; } }
            u32x4 bw; bw.x = pk2(wv[0], wv[1]); bw.y = pk2(wv[2], wv[3]); bw.z = pk2(wv[4], wv[5]); bw.w = pk2(wv[6], wv[7]);
            const bf16x8 bfrag = __builtin_bit_cast(bf16x8, bw);
#pragma unroll
            for (int p = 0; p < 4; ++p)
#pragma unroll
                for (int n = 0; n < 2; ++n) { const int c = 32 * p + 8 * (fr >> 2) + 4 * n + (fr & 3);
                    const bf16x8 afrag = *(const LAS bf16x8*)(VT + c * 272 + ((((4 * kk + fq) ^ (c >> 3)) & 15) << 4));
                    acc[p][n] = __builtin_amdgcn_mfma_f32_16x16x32_bf16(afrag, bfrag, acc[p][n], 0, 0, 0); }
        }
        { const float bsv = b_s[g * 128 + (sample ? (t & 3) : t)];
#pragma unroll
          for (int p = 0; p < 4; ++p) { float ux[8]; unpack8(uu[p], ux);
              u32x4 o; o.x = pk2(ux[0] * (acc[p][0][0] + bsv), ux[1] * (acc[p][0][1] + bsv)); o.y = pk2(ux[2] * (acc[p][0][2] + bsv), ux[3] * (acc[p][0][3] + bsv));
              o.z = pk2(ux[4] * (acc[p][1][0] + bsv), ux[5] * (acc[p][1][1] + bsv)); o.w = pk2(ux[6] * (acc[p][1][2] + bsv), ux[7] * (acc[p][1][3] + bsv));
              *(u32x4*)(YA + (size_t)(r0 + t) * DM + g * 128 + 32 * p + 8 * fq) = o; } }
        { float w0[8], w1[8], w2[8];
#pragma unroll
          for (int h = 0; h < 2; ++h) { const f32x4 a = *(const f32x4*)(cbw + cc + 4 * h), b = *(const f32x4*)(cbw + DM + cc + 4 * h), d = *(const f32x4*)(cbw + 2 * DM + cc + 4 * h);
#pragma unroll
              for (int i = 0; i < 4; ++i) { w0[4 * h + i] = a[i]; w1[4 * h + i] = b[i]; w2[4 * h + i] = d[i]; } }
#pragma unroll
          for (int k = 0; k < 4; ++k) { float a[8], b[8], o[8]; unpack8(pp[k], a); unpack8(bb[k], b);
#pragma unroll
              for (int j = 0; j < 8; ++j) { o[j] = (w0[j] * h2[j] + w1[j] * h1[j] + w2[j] * a[j]) * b[j]; h2[j] = h1[j]; h1[j] = a[j]; }
              u32x4 ov; ov.x = pk2(o[0], o[1]); ov.y = pk2(o[2], o[3]); ov.z = pk2(o[4], o[5]); ov.w = pk2(o[6], o[7]);
              *(u32x4*)(YB + (size_t)(rc + k) * DM + cc) = ov;
              float* so = nullptr;
              if (sample) { if (k >= 2) so = F.out + O_CBS + ((size_t)((rc - MP) >> 2) * 2 + (k - 2)) * DM + cc; }
              else { const int tt = (rc & (SEQ - 1)) + k; if (tt >= SEQ - 2) so = F.out + O_CBP + ((size_t)(rc / SEQ) * 2 + (tt - (SEQ - 2))) * DM + cc; }
              if (so) { *(f32x4*)so = (f32x4){a[0], a[1], a[2], a[3]}; *(f32x4*)(so + 4) = (f32x4){a[4], a[5], a[6], a[7]}; } } }
        __syncthreads();
    }
}

__device__ __forceinline__ void p_x1h2(Frame& F) {
    const int gw = F.vcu * NWAVES + F.wave, NGW = F.G * NWAVES;
    const bf16_t* T = (const bf16_t*)(F.ws + WS_T); bf16_t* H2 = (bf16_t*)(F.ws + WS_H2); const float* MOD = (const float*)(F.ws + WS_MOD);
    const float* g_post = F.in[9]; const float* g_pre2 = F.in[18];
    for (int r = gw; r < M; r += NGW) {
        const float* xrow = r < MP ? F.in[0] + (size_t)r * DM : F.in[1] + (size_t)(r - MP) * DM;
        const int bidx = r < MP ? r / SEQ : NB + (r - MP) / DS;
        const float* mod = MOD + (size_t)bidx * NMODC;
        float tv[4][8]; float s = 0.f;
#pragma unroll
        for (int j = 0; j < 4; ++j) { const u32x4 raw = *(const u32x4*)(T + (size_t)r * DM + 8 * F.lane + 512 * j);
            tv[j][0] = bf_lo(raw.x); tv[j][1] = bf_hi(raw.x); tv[j][2] = bf_lo(raw.y); tv[j][3] = bf_hi(raw.y); tv[j][4] = bf_lo(raw.z); tv[j][5] = bf_hi(raw.z); tv[j][6] = bf_lo(raw.w); tv[j][7] = bf_hi(raw.w);
#pragma unroll
            for (int k = 0; k < 8; ++k) s += tv[j][k] * tv[j][k]; }
        const float rstdT = 1.0f / sqrtf(wave_sum(s) * (1.0f / DM) + EPS);
        float s1 = 0.f;
#pragma unroll
        for (int j = 0; j < 4; ++j) { const int c = 8 * F.lane + 512 * j;
#pragma unroll
            for (int h = 0; h < 2; ++h) { const f32x4 xv = *(const f32x4*)(xrow + c + 4 * h), gp = *(const f32x4*)(g_post + c + 4 * h), gt = *(const f32x4*)(mod + 2 * DM + c + 4 * h);
                f32x4 x1;
#pragma unroll
                for (int k = 0; k < 4; ++k) { x1[k] = xv[k] + gt[k] * (tv[j][4 * h + k] * rstdT * gp[k]); tv[j][4 * h + k] = x1[k]; s1 += x1[k] * x1[k]; }
                *(f32x4*)(F.out + O_Y + (size_t)r * DM + c + 4 * h) = x1; } }
        const float rstd1 = 1.0f / sqrtf(wave_sum(s1) * (1.0f / DM) + EPS);
#pragma unroll
        for (int j = 0; j < 4; ++j) { const int c = 8 * F.lane + 512 * j; float h2[8];
#pragma unroll
            for (int h = 0; h < 2; ++h) { const f32x4 gp = *(const f32x4*)(g_pre2 + c + 4 * h), sh = *(const f32x4*)(mod + 3 * DM + c + 4 * h), sc = *(const f32x4*)(mod + 4 * DM + c + 4 * h);
#pragma unroll
                for (int k = 0; k < 4; ++k) h2[4 * h + k] = tv[j][4 * h + k] * rstd1 * gp[k] * (1.0f + sc[k]) + sh[k]; }
            u32x4 o; o.x = pk2(h2[0], h2[1]); o.y = pk2(h2[2], h2[3]); o.z = pk2(h2[4], h2[5]); o.w = pk2(h2[6], h2[7]);
            *(u32x4*)(H2 + (size_t)r * DM + c) = o; }
    }
}


__device__ __forceinline__ void p_ffn_fix(Frame& F) {
    const float* SA = (const float*)(F.ws + WS_SA); const float* SB = (const float*)(F.ws + WS_SB); const float* SAS = (const float*)(F.ws + WS_SAS); const float* SBS = (const float*)(F.ws + WS_SBS);
    bf16_t* G = (bf16_t*)(F.ws + WS_G); const float* cw = F.in[21]; const float* state = F.in[5];
    constexpr int C4 = DFF / 4;
    const int gtid = F.vcu * (NWAVES * 64) + F.tid, NT = F.G * NWAVES * 64;
    const f32x4 z4 = {0.f, 0.f, 0.f, 0.f};
    for (int idx = gtid; idx < 256 * C4; idx += NT) {
        const int c = (idx % C4) * 4, ri = idx / C4, rb64 = ri >> 1, which = ri & 1, r = 64 * rb64 + which; const bool ss = (rb64 & 31) == 0;
        const f32x4 a = *(const f32x4*)(SA + (size_t)(rb64 * 4 + 2 + which) * DFF + c), b = *(const f32x4*)(SB + (size_t)(rb64 * 2 + which) * DFF + c);
        f32x4 p1, p2;
        if (which == 0) { p1 = ss ? z4 : *(const f32x4*)(SA + (size_t)((rb64 - 1) * 4 + 1) * DFF + c); p2 = ss ? z4 : *(const f32x4*)(SA + (size_t)((rb64 - 1) * 4 + 0) * DFF + c); }
        else { p1 = *(const f32x4*)(SA + (size_t)(rb64 * 4 + 2) * DFF + c); p2 = ss ? z4 : *(const f32x4*)(SA + (size_t)((rb64 - 1) * 4 + 1) * DFF + c); }
        const f32x4 w0 = *(const f32x4*)(cw + c), w1 = *(const f32x4*)(cw + DFF + c), w2 = *(const f32x4*)(cw + 2 * DFF + c);
        float o[4];
#pragma unroll
        for (int i = 0; i < 4; ++i) o[i] = pg8::gelu_fast(w0[i] * p2[i] + w1[i] * p1[i] + w2[i] * a[i]) * b[i];
        u32x2 ov; ov.x = pk2(o[0], o[1]); ov.y = pk2(o[2], o[3]);
        *(u32x2*)(G + (size_t)r * DFF + c) = ov;
    }
    for (int idx = gtid; idx < NB * 2 * C4; idx += NT) {
        const int c = (idx % C4) * 4, ri = idx / C4, bb = ri >> 1, k = ri & 1;
        *(f32x4*)(F.out + O_CFP + (size_t)ri * DFF + c) = *(const f32x4*)(SA + (size_t)((bb * 32 + 31) * 4 + k) * DFF + c);
    }
    for (int idx = gtid; idx < DB * C4; idx += NT) {
        const int c = (idx % C4) * 4, sb = idx / C4;
        const f32x4 w0 = *(const f32x4*)(cw + c), w1 = *(const f32x4*)(cw + DFF + c), w2 = *(const f32x4*)(cw + 2 * DFF + c);
        f32x4 p2 = *(const f32x4*)(state + ((size_t)sb * 2 + 0) * DFF + c), p1 = *(const f32x4*)(state + ((size_t)sb * 2 + 1) * DFF + c);
#pragma unroll
        for (int tt = 0; tt < 4; ++tt) {
            const f32x4 a = *(const f32x4*)(SAS + (size_t)(sb * 4 + tt) * DFF + c), b = *(const f32x4*)(SBS + (size_t)(sb * 4 + tt) * DFF + c);
            float o[4];
#pragma unroll
            for (int i = 0; i < 4; ++i) o[i] = pg8::gelu_fast(w0[i] * p2[i] + w1[i] * p1[i] + w2[i] * a[i]) * b[i];
            u32x2 ov; ov.x = pk2(o[0], o[1]); ov.y = pk2(o[2], o[3]);
            *(u32x2*)(G + (size_t)(MP + sb * 4 + tt) * DFF + c) = ov;
            if (tt >= 2) *(f32x4*)(F.out + O_CFS + ((size_t)sb * 2 + (tt - 2)) * DFF + c) = a;
            p2 = p1; p1 = a;
        }
    }
}

__device__ __forceinline__ void p_final(Frame& F) {
    const int gw = F.vcu * NWAVES + F.wave, NGW = F.G * NWAVES;
    const bf16_t* Fb = (const bf16_t*)(F.ws + WS_F); const float* MOD = (const float*)(F.ws + WS_MOD); const float* g_post = F.in[19];
    for (int r = gw; r < M; r += NGW) {
        const int bidx = r < MP ? r / SEQ : NB + (r - MP) / DS;
        const float* mod = MOD + (size_t)bidx * NMODC;
        float tv[4][8]; float s = 0.f;
#pragma unroll
        for (int j = 0; j < 4; ++j) { const u32x4 raw = *(const u32x4*)(Fb + (size_t)r * DM + 8 * F.lane + 512 * j);
            tv[j][0] = bf_lo(raw.x); tv[j][1] = bf_hi(raw.x); tv[j][2] = bf_lo(raw.y); tv[j][3] = bf_hi(raw.y); tv[j][4] = bf_lo(raw.z); tv[j][5] = bf_hi(raw.z); tv[j][6] = bf_lo(raw.w); tv[j][7] = bf_hi(raw.w);
#pragma unroll
            for (int k = 0; k < 8; ++k) s += tv[j][k] * tv[j][k]; }
        const float rstd = 1.0f / sqrtf(wave_sum(s) * (1.0f / DM) + EPS);
#pragma unroll
        for (int j = 0; j < 4; ++j) { const int c = 8 * F.lane + 512 * j;
#pragma unroll
            for (int h = 0; h < 2; ++h) { float* yp = F.out + O_Y + (size_t)r * DM + c + 4 * h;
                const f32x4 xv = *(const f32x4*)yp, gp = *(const f32x4*)(g_post + c + 4 * h), gt = *(const f32x4*)(mod + 5 * DM + c + 4 * h);
                f32x4 y;
#pragma unroll
                for (int k = 0; k < 4; ++k) y[k] = xv[k] + gt[k] * (tv[j][4 * h + k] * rstd * gp[k]);
                *(f32x4*)yp = y; } }
    }
}

__global__ void __launch_bounds__(NWAVES * 64, 2) fwd_megakernel(Args args) {
    extern __shared__ __attribute__((aligned(16))) unsigned char lds[];
    Frame F;
    F.lds = (LAS unsigned char*)lds;
    F.tid = threadIdx.x; F.lane = F.tid & 63; F.wave = __builtin_amdgcn_readfirstlane(F.tid >> 6);
    F.G = gridDim.x; { const int bx = blockIdx.x; F.vcu = (F.G % 8 == 0) ? (bx % 8) * (F.G / 8) + bx / 8 : bx; }
    F.in = args.in; F.out = args.out; F.ws = args.ws;
    unsigned char* ws = args.ws;
    volatile LAS unsigned* MISC = (volatile LAS unsigned*)(F.lds + MISC_OFF);
    for (int u = F.tid; u < (LDS_BYTES - LDSCTL_OFF) / 4; u += NWAVES * 64) ((LAS unsigned*)(F.lds + LDSCTL_OFF))[u] = 0u;
    __syncthreads();
    XcdBarrier bar; bar.bar = (unsigned*)(ws + WS_CTL) + CW_BAR; bar.x = 0; bar.st = nullptr;
    if (N_LAUNCHES == 1) bar = xcd_barrier_post((unsigned*)(ws + WS_CTL) + CW_BAR, MISC + 8);
    const int lo = args.ph_lo, hi = args.ph_hi;
#define IN(k) (lo <= (k) && (k) < hi)
#define SEAM(k) do { if (IN(k) && IN((k) + 1)) xcd_barrier(bar); } while (0)
    using namespace pg8;
    LAS unsigned char* ring = F.lds + RING_OFF;
    const int cid = (int)blockIdx.x;

    if (IN(0)) { p0_prologue(F); } SEAM(0);
    if (IN(1)) {
        sg::EpiF32B E{(float*)(ws + WS_MOD), NMODC, F.in[7]};
        for (int u = F.vcu; u < 3 * (NMODC / 64); u += F.G) { const int pn = u / 3, pmr = u % 3;
            sg::small_gemm(ring, (const bf16_t*)(ws + WS_S), (const bf16_t*)(ws + WS_WADA), nullptr, nullptr, DM, DM, DM, 1, 64 * pmr, 64 * pn, E); }
    } SEAM(1);
    if (IN(2)) { p_h1(F); } SEAM(2);
    if (IN(3)) {
        Ptrs g{(const bf16_t*)(ws + WS_H1), (const bf16_t*)(ws + WS_WIN), nullptr, nullptr, DM, DM};
        StaticOrder S; S.init(M / 256, INW / 256, F.G, cid, 1);
        EpiIn E{(bf16_t*)(ws + WS_U), (bf16_t*)(ws + WS_V), (bf16_t*)(ws + WS_BG), (bf16_t*)(ws + WS_P), (bf16_t*)(ws + WS_SGA), (bf16_t*)(ws + WS_SGB), (float*)(ws + WS_VSS)};
        gemm_phase<EpiIn, StaticOrder, K_ALIGN, K_SP2>(ring, g, DM, S, E);
    } SEAM(3);
    if (IN(4)) { p_gate(F); } SEAM(4);
    if (IN(5)) {
        Ptrs g{(const bf16_t*)(ws + WS_YB), (const bf16_t*)(ws + WS_WB), (const bf16_t*)(ws + WS_YA), (const bf16_t*)(ws + WS_WA), DM, DM};
        StaticOrder S; S.init(MP / 256, DM / 256, F.G, cid, 2);
        EpiOut E{(const bf16_t*)(ws + WS_SGA), (const bf16_t*)(ws + WS_SGB), (bf16_t*)(ws + WS_MERGED)};
        gemm_phase<EpiOut, StaticOrder, K_ALIGN, K_SP2>(ring, g, DM, S, E);
        sg::EpiOutS Es{(const bf16_t*)(ws + WS_SGA), (const bf16_t*)(ws + WS_SGB), (bf16_t*)(ws + WS_MERGED)};
        for (int u = cid; u < (MS / 64) * (DM / 64); u += F.G)
            sg::small_gemm(ring, g.A0, g.B0, g.A1, g.B1, DM, DM, DM, 2, MP + 64 * (u / (DM / 64)), 64 * (u % (DM / 64)), Es);
    } SEAM(5);
    if (IN(6)) {
        Ptrs g{(const bf16_t*)(ws + WS_MERGED), (const bf16_t*)(ws + WS_WO), nullptr, nullptr, DM, DM};
        StaticOrder S; S.init(MP / 256, DM / 256, F.G, cid, 1);
        EpiBf16 E{(bf16_t*)(ws + WS_T), DM};
        gemm_phase<EpiBf16, StaticOrder, K_ALIGN, K_SP2>(ring, g, DM, S, E);
        sg::EpiSum Es{(bf16_t*)(ws + WS_T), DM};
        for (int u = cid; u < (MS / 64) * (DM / 64); u += F.G)
            sg::small_gemm(ring, g.A0, g.B0, nullptr, nullptr, DM, DM, DM, 1, MP + 64 * (u / (DM / 64)), 64 * (u % (DM / 64)), Es);
    } SEAM(6);
    if (IN(7)) { p_x1h2(F); } SEAM(7);
    if (IN(8)) {
        Ptrs g{(const bf16_t*)(ws + WS_H2), (const bf16_t*)(ws + WS_WUP), nullptr, nullptr, DM, DM};
        StaticOrder S; S.init(M / 256, 2 * DFF / 256, F.G, cid, 1);
        EpiUpF E{(bf16_t*)(ws + WS_G), (float*)(ws + WS_SA), (float*)(ws + WS_SB), (float*)(ws + WS_SAS), (float*)(ws + WS_SBS), F.in[21]};
        gemm_phase<EpiUpF, StaticOrder, K_ALIGN, K_SP2>(ring, g, DM, S, E);
    } SEAM(8);
    if (IN(9)) { p_ffn_fix(F); } SEAM(9);
    if (IN(10)) {
        Ptrs g{(const bf16_t*)(ws + WS_G), (const bf16_t*)(ws + WS_WD), nullptr, nullptr, DFF, DFF};
        StaticOrder S; S.init(MP / 256, DM / 256, F.G, cid, 1);
        EpiBf16 E{(bf16_t*)(ws + WS_F), DM};
        gemm_phase<EpiBf16, StaticOrder, K_ALIGN, K_SP2>(ring, g, DFF, S, E);
        sg::EpiSum Es{(bf16_t*)(ws + WS_F), DM};
        for (int u = cid; u < (MS / 64) * (DM / 64); u += F.G)
            sg::small_gemm(ring, g.A0, g.B0, nullptr, nullptr, DFF, DFF, DFF, 1, MP + 64 * (u / (DM / 64)), 64 * (u % (DM / 64)), Es);
    } SEAM(10);
    if (IN(11)) { p_final(F); }
#undef IN
#undef SEAM
}

extern "C" void kernel_launch(void* const* d_in, const int* in_sizes, int n_in, void* d_out, int out_size, void* d_ws, size_t ws_size, hipStream_t stream) {
    static int grid = 0;
    if (grid == 0) {
        if (n_in != 23 || out_size != (int)O_END || ws_size < WS_END) { fprintf(stderr, "kernel_launch: unexpected shapes: n_in %d out %d ws %zu (need %zu)\n", n_in, out_size, ws_size, (size_t)WS_END); grid = -1; return; }
        int dev = 0, cus = 0, per_cu = 0;
        if (hipGetDevice(&dev) != hipSuccess || hipDeviceGetAttribute(&cus, hipDeviceAttributeMultiprocessorCount, dev) != hipSuccess) { grid = -1; return; }
        if (hipFuncSetAttribute((const void*)fwd_megakernel, hipFuncAttributeMaxDynamicSharedMemorySize, LDS_BYTES) != hipSuccess) { fprintf(stderr, "kernel_launch: hipFuncSetAttribute failed\n"); grid = -1; return; }
        if (hipOccupancyMaxActiveBlocksPerMultiprocessor(&per_cu, (const void*)fwd_megakernel, NWAVES * 64, LDS_BYTES) != hipSuccess || per_cu < 1) { fprintf(stderr, "kernel_launch: occupancy query says %d blocks per CU\n", per_cu); (void)hipGetLastError(); grid = -1; return; }
        grid = cus;
    }
    if (grid < 0) return;
    (void)hipMemsetAsync((char*)d_ws + WS_CTL, 0, CTL_ZERO_BYTES, stream);
    Args a{};
    for (int i = 0; i < 23; ++i) a.in[i] = (const float*)d_in[i];
    a.out = (float*)d_out; a.ws = (unsigned char*)d_ws;
    if (N_LAUNCHES == 1) {
        a.ph_lo = 0; a.ph_hi = NPHASES; a.li = 0;
        hipLaunchKernelGGL(fwd_megakernel, dim3(grid), dim3(NWAVES * 64), LDS_BYTES, stream, a);
    } else {
        for (int li = 0; li < NPHASES; ++li) { a.ph_lo = li; a.ph_hi = li + 1; a.li = li;
            hipLaunchKernelGGL(fwd_megakernel, dim3(grid), dim3(NWAVES * 64), LDS_BYTES, stream, a); }
    }
    const hipError_t le = hipPeekAtLastError();
    if (le != hipSuccess) fprintf(stderr, "kernel_launch: launch failed: %s\n", hipGetErrorName(le));
}
```
